# Optimizing an MI355X kernel written in HIP

```python
import math
import jax, jax.numpy as jnp
from jax import lax
import numpy as np

D_MODEL = 1024
BATCH = 8
SEQ = 2048
DEPTH = 1
DEC_BATCH = 32
DEC_SEQ = 8
PAST_LEN = 8192
PAGE_SIZE = 128

HEAD_DIM = 64
N_ATT_HEADS = 8
ATT_BRANCHES = ((128, 1), (512, 4), (2048, 16))
MAX_WINDOW = 2048
ROPE_THETA = 500000.0
ROPE_DIM = HEAD_DIM // 4
N_RET_HEADS = 4
RET_QK_DIM = 64
RET_V_DIM = 128
RET_THETA = 10000.0
RET_CHUNK = 128
ATT_WIDTH = N_ATT_HEADS * HEAD_DIM
RET_QK_WIDTH = N_RET_HEADS * RET_QK_DIM
RET_V_WIDTH = N_RET_HEADS * RET_V_DIM
MIX_WIDTH = ATT_WIDTH + RET_V_WIDTH
IN_WIDTH = 3 * ATT_WIDTH + 2 * RET_QK_WIDTH + 2 * RET_V_WIDTH
D_FF = 4 * D_MODEL
EPS = 1e-6

kernel_name = 'hybrid_dilated_attn_retention_decode_step'

F32 = jnp.float32


def _rms(x):
    x32 = x.astype(F32)
    return (x32 * lax.rsqrt(jnp.mean(x32 * x32, axis=-1, keepdims=True) + EPS)).astype(x.dtype)


def _adaln(c, w, b, n):
    mod = jnp.dot(jax.nn.silu(c), w) + b
    return jnp.split(mod[:, None, :], n, axis=-1)


def _partial_rope(x, pos):
    half = ROPE_DIM // 2
    inv = ROPE_THETA ** (-jnp.arange(0, ROPE_DIM, 2, dtype=F32) / ROPE_DIM)
    ang = pos.astype(F32)[:, None] * inv[None, :]
    cos = jnp.cos(ang)[None, :, None, :]
    sin = jnp.sin(ang)[None, :, None, :]
    x32 = x.astype(F32)
    x1 = x32[..., :half]
    x2 = x32[..., half:ROPE_DIM]
    out = jnp.concatenate([x1 * cos - x2 * sin, x2 * cos + x1 * sin, x32[..., ROPE_DIM:]], axis=-1)
    return out.astype(x.dtype)


def _ret_rotate(x, pos):
    inv = RET_THETA ** (-jnp.linspace(0.0, 1.0, RET_QK_DIM // 2, dtype=F32))
    ang = pos.astype(F32)[:, None] * inv[None, :]
    cos = jnp.cos(ang)[None, :, None, :]
    sin = jnp.sin(ang)[None, :, None, :]
    xr = x.astype(F32).reshape(x.shape[:-1] + (RET_QK_DIM // 2, 2))
    x1, x2 = xr[..., 0], xr[..., 1]
    return jnp.stack([x1 * cos - x2 * sin, x2 * cos + x1 * sin], axis=-1).reshape(x.shape)


def _project(z, w_in, pos):
    B, T, _ = z.shape
    p = jnp.dot(z, w_in)
    o1 = ATT_WIDTH
    o2 = o1 + ATT_WIDTH
    o3 = o2 + ATT_WIDTH
    o4 = o3 + RET_QK_WIDTH
    o5 = o4 + RET_QK_WIDTH
    o6 = o5 + RET_V_WIDTH
    qa, ka, va, qr, kr, vr, gr = jnp.split(p, [o1, o2, o3, o4, o5, o6], axis=-1)
    qa = _partial_rope(qa.reshape(B, T, N_ATT_HEADS, HEAD_DIM), pos)
    ka = _partial_rope(ka.reshape(B, T, N_ATT_HEADS, HEAD_DIM), pos)
    va = va.reshape(B, T, N_ATT_HEADS, HEAD_DIM)
    qr = _ret_rotate(qr.reshape(B, T, N_RET_HEADS, RET_QK_DIM), pos)
    kr = _ret_rotate(kr.reshape(B, T, N_RET_HEADS, RET_QK_DIM), pos) * (RET_QK_DIM ** -0.5)
    vr = vr.reshape(B, T, N_RET_HEADS, RET_V_DIM).astype(F32)
    return qa, ka, va, qr, kr, vr, gr


def _masked_softmax(s, valid):
    s = jnp.where(valid, s, -jnp.inf)
    m = jnp.max(s, axis=-1, keepdims=True)
    p = jnp.exp(s - m)
    l = jnp.sum(p, axis=-1, keepdims=True)
    return p / l, (m + jnp.log(l))[..., 0]


def _dilated_branch_prompt(q, k, v, window, dil):
    B, S, H, Dh = q.shape
    n = window // dil
    M = S // dil
    nb = -(-M // n)
    pad = nb * n - M

    def blocks(t):
        t = t.reshape(B, M, dil, H, Dh).transpose(0, 2, 1, 3, 4)
        t = jnp.pad(t, ((0, 0), (0, 0), (0, pad), (0, 0), (0, 0)))
        return t.reshape(B, dil, nb, n, H, Dh)

    def with_prev(t):
        prev = jnp.pad(t, ((0, 0), (0, 0), (1, 0), (0, 0), (0, 0), (0, 0)))[:, :, :nb]
        return jnp.concatenate([prev, t], axis=3)

    qb = blocks(q)
    kw = with_prev(blocks(k))
    vw = with_prev(blocks(v))
    s = jnp.einsum('brcqhd,brckhd->brchqk', qb, kw).astype(F32) * (HEAD_DIM ** -0.5)
    qi = jnp.arange(n)[:, None]
    kj = jnp.arange(2 * n)[None, :]
    dist = qi + n - kj
    kg = jnp.arange(nb)[:, None, None] * n - n + kj[None]
    valid = (dist[None] >= 0) & (dist[None] <= n) & (kg >= 0)
    p, lse = _masked_softmax(s, valid[None, None, :, None])
    o = jnp.einsum('brchqk,brckhd->brcqhd', p, vw.astype(F32))
    o = o.reshape(B, dil, nb * n, H, Dh)[:, :, :M].transpose(0, 2, 1, 3, 4).reshape(B, S, H, Dh)
    lse = lse.transpose(0, 1, 2, 4, 3).reshape(B, dil, nb * n, H)[:, :, :M]
    lse = lse.transpose(0, 2, 1, 3).reshape(B, S, H)
    return o, lse


def _dilated_branch_sample(q, k_all, v_all, L, window, dil):
    T = q.shape[1]
    n = window // dil
    idx = L + jnp.arange(T)[:, None] - dil * jnp.arange(n + 1)[None, :]
    valid = idx >= 0
    idxc = jnp.maximum(idx, 0)
    kg = k_all[:, idxc]
    vg = v_all[:, idxc]
    s = jnp.einsum('bqhd,bqkhd->bhqk', q, kg).astype(F32) * (HEAD_DIM ** -0.5)
    p, lse = _masked_softmax(s, valid[None, None])
    o = jnp.einsum('bhqk,bqkhd->bqhd', p, vg.astype(F32))
    return o, lse.transpose(0, 2, 1)


def _combine(outs, lses):
    w = jax.nn.softmax(jnp.stack(lses, axis=0), axis=0)
    return jnp.sum(w[..., None] * jnp.stack(outs, axis=0), axis=0)


def _retention(q, k, v, state0):
    B, T, H, dk = q.shape
    dv = v.shape[-1]
    chunk = math.gcd(T, RET_CHUNK)
    nc = T // chunk
    log_g = jnp.log1p(-jnp.exp2(-5.0 - jnp.arange(H, dtype=F32)))
    i = jnp.arange(chunk, dtype=F32)
    rel = i[:, None] - i[None, :]
    dmask = jnp.where(rel[None] >= 0, jnp.exp(jnp.maximum(rel, 0.0)[None] * log_g[:, None, None]), 0.0)
    qc = q.reshape(B, nc, chunk, H, dk)
    kc = k.reshape(B, nc, chunk, H, dk)
    vc = v.reshape(B, nc, chunk, H, dv)
    s = jnp.einsum('bnqhd,bnkhd->bnhqk', qc, kc) * dmask
    inner = jnp.einsum('bnhqk,bnkhe->bnqhe', s, vc)
    d_in = jnp.exp((chunk - 1.0 - i)[:, None] * log_g[None, :])
    d_out = jnp.exp((i + 1.0)[:, None] * log_g[None, :])
    kv = jnp.einsum('bnkhd,bnkhe->nbhde', kc * d_in[:, :, None], vc)
    g_chunk = jnp.exp(chunk * log_g)[None, :, None, None]

    def step(st, kv_c):
        return g_chunk * st + kv_c, st

    s_final, s_prev = lax.scan(step, state0, kv)
    cross = jnp.einsum('bnqhd,nbhde->bnqhe', qc * d_out[:, :, None], s_prev)
    return (inner + cross).reshape(B, T, H, dv), s_final


def _ret_out(o, g, gain):
    B, T = o.shape[:2]
    mu = jnp.mean(o, axis=-1, keepdims=True)
    var = jnp.mean(jnp.square(o - mu), axis=-1, keepdims=True)
    on = ((o - mu) * lax.rsqrt(var + EPS)).reshape(B, T, RET_V_WIDTH) * gain
    return jax.nn.silu(g.astype(F32)) * on


def _mlp(z, w1, w2):
    return jnp.dot(jnp.square(jax.nn.relu(jnp.dot(z, w1))), w2)


def _prompt_layer(x, c, w_ada, b_ada, w_in, ret_gain, w_out, w_ff1, w_ff2):
    B, S, _ = x.shape
    pos = jnp.arange(S, dtype=jnp.int32)
    sh_a, sc_a, g_a, sh_f, sc_f, g_f = _adaln(c, w_ada, b_ada, 6)
    z = _rms(x) * (1 + sc_a) + sh_a
    qa, ka, va, qr, kr, vr, gr = _project(z, w_in, pos)
    outs, lses = [], []
    for window, dil in ATT_BRANCHES:
        o, lse = _dilated_branch_prompt(qa, ka, va, window, dil)
        outs.append(o)
        lses.append(lse)
    att = _combine(outs, lses).reshape(B, S, ATT_WIDTH)
    state0 = jnp.zeros((B, N_RET_HEADS, RET_QK_DIM, RET_V_DIM), F32)
    ret, state = _retention(qr, kr, vr, state0)
    mix = jnp.concatenate([att, _ret_out(ret, gr, ret_gain)], axis=-1).astype(x.dtype)
    x = x + g_a * jnp.dot(mix, w_out)
    x = x + g_f * _mlp(_rms(x) * (1 + sc_f) + sh_f, w_ff1, w_ff2)
    keep = min(MAX_WINDOW, S)
    return x, ka[:, S - keep:], va[:, S - keep:], state


def _sample_layer(x, c, ck, cv, st, w_ada, b_ada, w_in, ret_gain, w_out, w_ff1, w_ff2):
    DB, T, _ = x.shape
    L = ck.shape[1]
    pos = PAST_LEN + jnp.arange(T, dtype=jnp.int32)
    sh_a, sc_a, g_a, sh_f, sc_f, g_f = _adaln(c, w_ada, b_ada, 6)
    z = _rms(x) * (1 + sc_a) + sh_a
    qa, ka, va, qr, kr, vr, gr = _project(z, w_in, pos)
    k_all = jnp.concatenate([ck.astype(ka.dtype), ka], axis=1)
    v_all = jnp.concatenate([cv.astype(va.dtype), va], axis=1)
    outs, lses = [], []
    for window, dil in ATT_BRANCHES:
        o, lse = _dilated_branch_sample(qa, k_all, v_all, L, window, dil)
        outs.append(o)
        lses.append(lse)
    att = _combine(outs, lses).reshape(DB, T, ATT_WIDTH)
    ret, state = _retention(qr, kr, vr, st.astype(F32))
    mix = jnp.concatenate([att, _ret_out(ret, gr, ret_gain)], axis=-1).astype(x.dtype)
    x = x + g_a * jnp.dot(mix, w_out)
    x = x + g_f * _mlp(_rms(x) * (1 + sc_f) + sh_f, w_ff1, w_ff2)
    return x, ka, va, state


def _final_norm(x, c, w, b):
    sh, sc = _adaln(c, w, b, 2)
    return _rms(x) * (1 + sc) + sh


def setup_inputs(seed: int = 0) -> dict:
    key = jax.random.key(seed)
    ks = jax.random.split(key, 16)
    cache_len = min(MAX_WINDOW, PAST_LEN)

    def nrm(k, shape, s):
        return jax.random.normal(k, shape, F32) * s

    return {
        'x_prompt': nrm(ks[0], (BATCH, SEQ, D_MODEL), 1.0),
        'x_sample': nrm(ks[1], (DEC_BATCH, DEC_SEQ, D_MODEL), 1.0),
        'c_prompt': nrm(ks[2], (BATCH, D_MODEL), 1.0),
        'c_sample': nrm(ks[3], (DEC_BATCH, D_MODEL), 1.0),
        'cache_k': nrm(ks[4], (DEPTH, DEC_BATCH, cache_len, N_ATT_HEADS, HEAD_DIM), 1.0),
        'cache_v': nrm(ks[5], (DEPTH, DEC_BATCH, cache_len, N_ATT_HEADS, HEAD_DIM), 1.0),
        'state_ret': nrm(ks[6], (DEPTH, DEC_BATCH, N_RET_HEADS, RET_QK_DIM, RET_V_DIM), 1.0),
        'w_ada': nrm(ks[7], (DEPTH, D_MODEL, 6 * D_MODEL), 0.5 * D_MODEL ** -0.5),
        'b_ada': nrm(ks[8], (DEPTH, 6 * D_MODEL), 0.02),
        'w_in': nrm(ks[9], (DEPTH, D_MODEL, IN_WIDTH), D_MODEL ** -0.5),
        'ret_gain': 1.0 + nrm(ks[10], (DEPTH, RET_V_WIDTH), 0.02),
        'w_out': nrm(ks[11], (DEPTH, MIX_WIDTH, D_MODEL), MIX_WIDTH ** -0.5),
        'w_ff1': nrm(ks[12], (DEPTH, D_MODEL, D_FF), D_MODEL ** -0.5),
        'w_ff2': nrm(ks[13], (DEPTH, D_FF, D_MODEL), D_FF ** -0.5),
        'w_ada_f': nrm(ks[14], (D_MODEL, 2 * D_MODEL), 0.5 * D_MODEL ** -0.5),
        'b_ada_f': nrm(ks[15], (2 * D_MODEL,), 0.02),
    }


def reference(x_prompt, x_sample, c_prompt, c_sample, cache_k, cache_v, state_ret,
              w_ada, b_ada, w_in, ret_gain, w_out, w_ff1, w_ff2, w_ada_f, b_ada_f):
    xp, xs = x_prompt, x_sample
    kp_l, vp_l, sp_l, ks_l, vs_l, ss_l = [], [], [], [], [], []
    for l in range(DEPTH):
        xp, kp, vp, sp = _prompt_layer(xp, c_prompt, w_ada[l], b_ada[l], w_in[l], ret_gain[l],
                                       w_out[l], w_ff1[l], w_ff2[l])
        xs, ksn, vsn, ssn = _sample_layer(xs, c_sample, cache_k[l], cache_v[l], state_ret[l],
                                          w_ada[l], b_ada[l], w_in[l], ret_gain[l],
                                          w_out[l], w_ff1[l], w_ff2[l])
        kp_l.append(kp)
        vp_l.append(vp)
        sp_l.append(sp)
        ks_l.append(ksn)
        vs_l.append(vsn)
        ss_l.append(ssn)
    y_prompt = _final_norm(xp, c_prompt, w_ada_f, b_ada_f)
    y_sample = _final_norm(xs, c_sample, w_ada_f, b_ada_f)
    return (y_prompt, y_sample, jnp.stack(kp_l), jnp.stack(vp_l), jnp.stack(sp_l),
            jnp.stack(ks_l), jnp.stack(vs_l), jnp.stack(ss_l))
```

```cpp
#include <hip/hip_runtime.h>
#include <hip/hip_cooperative_groups.h>
#include <cstdio>
#include <cstdint>
namespace cg = cooperative_groups;

#ifndef MK_MULTI
#define MK_MULTI 0
#endif

#define LAS __attribute__((address_space(3)))
#define GAS __attribute__((address_space(1)))
typedef unsigned short bf16_t;
typedef short bf16x8 __attribute__((ext_vector_type(8)));
typedef short s16x4 __attribute__((ext_vector_type(4)));
typedef float f32x2 __attribute__((ext_vector_type(2)));
typedef float f32x4 __attribute__((ext_vector_type(4)));
typedef float f32x16 __attribute__((ext_vector_type(16)));
typedef unsigned u32x2 __attribute__((ext_vector_type(2)));
typedef unsigned u32x4 __attribute__((ext_vector_type(4)));
typedef __bf16 bf16x2_t __attribute__((ext_vector_type(2)));

constexpr int D = 1024, SEQ = 2048, NB = 8, DBT = 32, DT = 8;
constexpr int MP = NB * SEQ, MS = DBT * DT, M = MP + MS;
constexpr int NIN = 3072, FF = 4096, NMODB = NB + DBT;
constexpr int LCACHE = 2048;
constexpr float EPS = 1e-6f;
constexpr float QSCALE = 0.125f * 1.4426950408889634f;
constexpr size_t OFF_Y = 0, OFF_KP = 17039360, OFF_VP = 25427968, OFF_RP = 33816576, OFF_KS = 34078720, OFF_VS = 34209792, OFF_RS = 34340864;
constexpr int OUT_TOTAL = 35389440;

constexpr size_t MiB = 1u << 20;
constexpr size_t WS_CTL = 0;
constexpr size_t WS_MOD = 1 * MiB;
constexpr size_t WS_MODF = WS_MOD + (size_t)NMODB * 6144 * 4;
constexpr size_t WS_TABR = 3 * MiB;
constexpr size_t WS_TABT = WS_TABR + 2056 * 8 * 8;
constexpr size_t WS_WIN = 4 * MiB;
constexpr size_t WS_WOUT = 10 * MiB;
constexpr size_t WS_W1 = 12 * MiB;
constexpr size_t WS_W2 = 20 * MiB;
constexpr size_t WS_XN = 28 * MiB;
constexpr size_t WS_QA = 61 * MiB;
constexpr size_t WS_KA = 78 * MiB;
constexpr size_t WS_VA = 95 * MiB;
constexpr size_t WS_QR = 112 * MiB;
constexpr size_t WS_KR = 121 * MiB;
constexpr size_t WS_VR = 130 * MiB;
constexpr size_t WS_GR = 147 * MiB;
constexpr size_t WS_MIX = 164 * MiB;
constexpr size_t WS_KV = 197 * MiB;
constexpr size_t WS_X1 = 214 * MiB;
constexpr size_t WS_H = 280 * MiB;
constexpr size_t WS_END = 411 * MiB;

constexpr int NWAVES = 8, NTHREADS = 512;
constexpr int LDS_BYTES = 147456;

__device__ const double INVF[40] = {
    1.0, 0.19392274474868576, 0.03760603093086393, 0.007292664737217109, 0.001414213562373095, 0.0002742481756762073, 5.318295896944988e-05, 1.031338537721246e-05,
    1.0, 0.7429639507594948, 0.551995432128157, 0.41011270705513014, 0.30469895709035083, 0.22638034095214482, 0.16819243248808696, 0.1249609141291987,
    0.09284145445194744, 0.06897785379387654, 0.05124805876960934, 0.038075460212223716, 0.028288694346259694, 0.021017480113324882, 0.015615230060004972,
    0.011601553017399714, 0.008619535664753033, 0.006404004271197283, 0.004757944314009409, 0.0035349811050301057, 0.0026263635276533325, 0.0019512934226359642,
    0.0014497406703726315, 0.001077105056036769, 0.0008002502278161052, 0.0005945570708544394, 0.00044173447031400687, 0.0003281927872511474,
    0.0002438354098268829, 0.00018116091942004152, 0.00013459603241553644, 0.0001};
__device__ __forceinline__ float log2g_of(int h) { return h == 0 ? -0.04580368961312479f : h == 1 ? -0.02272007650008353f : h == 2 ? -0.011315313227834146f : -0.005646563141142063f; }

__device__ __forceinline__ unsigned cvtpk(float lo, float hi) { f32x2 v = {lo, hi}; bf16x2_t b = __builtin_convertvector(v, bf16x2_t); return __builtin_bit_cast(unsigned, b); }
__device__ __forceinline__ float bf2f(unsigned short u) { return __uint_as_float((unsigned)u << 16); }
__device__ __forceinline__ float bflo(unsigned u) { return __uint_as_float(u << 16); }
__device__ __forceinline__ float bfhi(unsigned u) { return __uint_as_float(u & 0xffff0000u); }
__device__ __forceinline__ int row_bidx(int r) { return r < MP ? (r >> 11) : NB + ((r - MP) >> 3); }
__device__ __forceinline__ int row_tab(int r) { return r < MP ? (r & 2047) : 2048 + ((r - MP) & 7); }
__device__ __forceinline__ float wave_sum(float v) {
#pragma unroll
    for (int o = 1; o < 64; o <<= 1) v += __shfl_xor(v, o);
    return v;
}

namespace pg8 {
#define PG8_LAS __attribute__((address_space(3)))
constexpr int BM = 256, BK = 64, HALF = 128, HTB = HALF * BK * 2, STAGE_BYTES = 8 * HTB, NXCD = 8, WGM = 8;
__host__ __device__ __forceinline__ int lds_byte(int r, int c) { const int st = (r >> 4) * 2 + (c >> 5), rr = r & 15, cc = c & 31, ob = rr * 64 + cc * 2; return st * 1024 + (ob ^ (((ob >> 9) & 1) << 5)); }
__host__ __device__ __forceinline__ void stage_rc(int b, int& R, int& C) { const int st = b / 1024, sb = b % 1024, swz = sb ^ (((sb >> 9) & 1) << 5); R = (st >> 1) * 16 + swz / 64; C = (st & 1) * 32 + (swz % 64) / 2; }
__host__ __device__ __forceinline__ int perm32(int rho) { const int n = rho >> 4, i = rho & 15; return 8 * (i >> 2) + 4 * n + (i & 3); }
struct Unit { int pm, pn; };
struct Gemm { const bf16_t* A; const bf16_t* Bt; int M, N, K; };
struct StaticOrder {
    int nM, nN, nwg, G, c;
    __host__ __device__ void init(int M_, int N_, int G_, int c_) { nM = M_ / BM; nN = N_ / BM; nwg = nM * nN; G = G_; c = c_; }
    __host__ __device__ bool next(int i, Unit& u) const {
        const long L = (long)i * G + c; if (L >= nwg) return false;
        int wgid = (int)L; { const int q = nwg / NXCD, r = nwg % NXCD, xcd = wgid % NXCD, off = wgid / NXCD; wgid = (xcd < r ? xcd * (q + 1) : r * (q + 1) + (xcd - r) * q) + off; }
        const int nig = WGM * nN, gid = wgid / nig, fm = gid * WGM, gsz = (nM - fm) < WGM ? (nM - fm) : WGM;
        u.pm = fm + ((wgid % nig) % gsz); u.pn = (wgid % nig) / gsz; return true;
    }
    __device__ __forceinline__ void a_ready(const Unit&) const {}
    __device__ __forceinline__ void done(const Unit&) const {}
};

template <class Epi, class Sched, bool ALIGN_EPI = false, bool SP2 = false>
__device__ __forceinline__ void gemm_phase(PG8_LAS unsigned char* lds, const Gemm g, const Sched& S, const Epi& E) {
    const int tid = threadIdx.x, wid = __builtin_amdgcn_readfirstlane(tid >> 6), lane = tid & 63, wr = wid >> 2, wc = wid & 3, fr = lane & 15, fq = lane >> 4;
    const int K = g.K, nt = K / BK;
    unsigned voffA[2], voffB[2];
#pragma unroll
    for (int i = 0; i < 2; ++i) { int R, C; stage_rc(tid * 16 + i * 8192, R, C); const int Rb = Epi::PERM ? ((R & ~31) + perm32(R & 31)) : R;
        voffA[i] = (unsigned)(R * K + C) * 2u; voffB[i] = (unsigned)(Rb * K + C) * 2u; }
    const size_t kstep = (size_t)(BK * 2);
    const size_t hstep = (size_t)HALF * K * 2;
    const size_t tstep = 2 * hstep;
    const unsigned ldsw = (unsigned)wid * 1024u;
    const int aoff = lds_byte(wr * 64 + fr, fq * 8), boff = lds_byte(wc * 32 + fr, fq * 8);
#define PG8_SA(b, h) (((b) * 2 + (h)) * HTB)
#define PG8_SB(b, h) ((4 + (b) * 2 + (h)) * HTB)
#define PG8_STAGE(bufoff, gbase, voff) do { _Pragma("unroll") for (int _i = 0; _i < 2; ++_i) \
        __builtin_amdgcn_global_load_lds((const unsigned*)((const char*)(gbase) + (voff)[_i]), (PG8_LAS unsigned*)(lds + (bufoff) + ldsw + _i * 8192), 16, 0, 0); } while (0)
#define PG8_LDA(dst, b, h) do { _Pragma("unroll") for (int m = 0; m < 4; ++m) _Pragma("unroll") for (int k = 0; k < 2; ++k) dst[m][k] = *(const PG8_LAS bf16x8*)(lds + PG8_SA(b, h) + aoff + m * 2048 + k * 1024); } while (0)
#define PG8_LDB(dst, b, h) do { _Pragma("unroll") for (int n = 0; n < 2; ++n) _Pragma("unroll") for (int k = 0; k < 2; ++k) dst[n][k] = *(const PG8_LAS bf16x8*)(lds + PG8_SB(b, h) + boff + n * 2048 + k * 1024); } while (0)
#define PG8_MMA(ai, bj, At, Bt) do { __builtin_amdgcn_s_setprio(1); _Pragma("unroll") for (int m = 0; m < 4; ++m) _Pragma("unroll") for (int n = 0; n < 2; ++n) _Pragma("unroll") for (int k = 0; k < 2; ++k) \
        acc[ai][bj][m][n] = __builtin_amdgcn_mfma_f32_16x16x32_bf16(Bt[n][k], At[m][k], acc[ai][bj][m][n], 0, 0, 0); __builtin_amdgcn_s_setprio(0); } while (0)
#define PG8_WAIT_V(n) asm volatile("s_waitcnt vmcnt(" #n ")" ::: "memory")
#define PG8_WAIT_L(n) asm volatile("s_waitcnt lgkmcnt(" #n ")" ::: "memory")
#define PG8_BAR __builtin_amdgcn_s_barrier()
#define PG8_SCHED __builtin_amdgcn_sched_barrier(0)
    Unit cur, nxt; int ui = 0;
    if (!S.next(0, cur)) return;
    f32x4 acc[2][2][4][2];
#pragma unroll
    for (int a = 0; a < 2; ++a)
#pragma unroll
        for (int b = 0; b < 2; ++b)
#pragma unroll
            for (int m = 0; m < 4; ++m)
#pragma unroll
                for (int n = 0; n < 2; ++n) acc[a][b][m][n] = (f32x4){0.f, 0.f, 0.f, 0.f};
    bf16x8 At[4][2], B0[2][2], B1[2][2];
    const char* cA = (const char*)g.A + (size_t)cur.pm * tstep; const char* cB = (const char*)g.Bt + (size_t)cur.pn * tstep;
    S.a_ready(cur);
    if constexpr (SP2) {
        PG8_STAGE(PG8_SB(0, 0), cB, voffB); PG8_STAGE(PG8_SB(0, 1), cB + hstep, voffB); PG8_STAGE(PG8_SA(0, 0), cA, voffA); PG8_STAGE(PG8_SA(0, 1), cA + hstep, voffA);
        if (wr == 1) PG8_BAR;
        PG8_WAIT_V(2); PG8_BAR;
        PG8_STAGE(PG8_SB(1, 0), cB + kstep, voffB); PG8_STAGE(PG8_SA(1, 0), cA + kstep, voffA); PG8_STAGE(PG8_SB(1, 1), cB + hstep + kstep, voffB);
        PG8_WAIT_V(6); PG8_BAR;
    } else {
        PG8_STAGE(PG8_SB(0, 0), cB, voffB); PG8_STAGE(PG8_SA(0, 0), cA, voffA); PG8_STAGE(PG8_SB(0, 1), cB + hstep, voffB); PG8_STAGE(PG8_SA(0, 1), cA + hstep, voffA);
        if (wr == 1) PG8_BAR;
        PG8_WAIT_V(4); PG8_BAR;
        PG8_STAGE(PG8_SB(1, 0), cB + kstep, voffB); PG8_STAGE(PG8_SA(1, 0), cA + kstep, voffA); PG8_STAGE(PG8_SB(1, 1), cB + hstep + kstep, voffB);
        PG8_WAIT_V(6); PG8_BAR;
    }
    for (;;) {
        const bool has_next = S.next(ui + 1, nxt);
        const char* nA = has_next ? (const char*)g.A + (size_t)nxt.pm * tstep : cA; const char* nB = has_next ? (const char*)g.Bt + (size_t)nxt.pn * tstep : cB;
        for (int t = 0; t < nt; t += 2) {
            const bool last = (t == nt - 2);
            const char* a1 = cA + (size_t)(t + 1) * kstep;
            const char* a2 = last ? nA : cA + (size_t)(t + 2) * kstep; const char* b2 = last ? nB : cB + (size_t)(t + 2) * kstep;
            const char* a3 = a2 + kstep; const char* b3 = b2 + kstep;
            if (last && has_next) S.a_ready(nxt);
            if constexpr (SP2) {
            PG8_LDB(B0, 0, 0); PG8_LDB(B1, 0, 1); PG8_SCHED; PG8_LDA(At, 0, 0); PG8_STAGE(PG8_SA(1, 1), a1 + hstep, voffA);
            PG8_WAIT_V(8); PG8_WAIT_L(0); PG8_BAR; PG8_MMA(0, 0, At, B0); PG8_MMA(0, 1, At, B1); PG8_BAR; PG8_SCHED;
            PG8_LDA(At, 0, 1); PG8_STAGE(PG8_SB(0, 0), b2, voffB); PG8_STAGE(PG8_SB(0, 1), b2 + hstep, voffB); PG8_STAGE(PG8_SA(0, 0), a2, voffA);
            PG8_WAIT_V(8); PG8_WAIT_L(0); PG8_BAR; PG8_MMA(1, 0, At, B0); PG8_MMA(1, 1, At, B1); PG8_BAR; PG8_SCHED;
            PG8_LDB(B0, 1, 0); PG8_LDB(B1, 1, 1); PG8_SCHED; PG8_LDA(At, 1, 0); PG8_STAGE(PG8_SA(0, 1), a2 + hstep, voffA);
            PG8_WAIT_V(8); PG8_WAIT_L(0); PG8_BAR; PG8_MMA(0, 0, At, B0); PG8_MMA(0, 1, At, B1); PG8_BAR; PG8_SCHED;
            PG8_LDA(At, 1, 1); PG8_STAGE(PG8_SB(1, 0), b3, voffB); PG8_STAGE(PG8_SB(1, 1), b3 + hstep, voffB); PG8_STAGE(PG8_SA(1, 0), a3, voffA);
            PG8_WAIT_V(8); PG8_WAIT_L(0); PG8_BAR; PG8_MMA(1, 0, At, B0); PG8_MMA(1, 1, At, B1); PG8_BAR; PG8_SCHED;
            } else {
            PG8_LDB(B0, 0, 0); PG8_SCHED; PG8_LDA(At, 0, 0); PG8_STAGE(PG8_SA(1, 1), a1 + hstep, voffA);
            PG8_WAIT_L(8); PG8_BAR; PG8_WAIT_L(0); PG8_MMA(0, 0, At, B0); PG8_BAR; PG8_SCHED;
            PG8_LDB(B1, 0, 1); PG8_STAGE(PG8_SB(0, 0), b2, voffB);
            PG8_BAR; PG8_WAIT_L(0); PG8_MMA(0, 1, At, B1); PG8_BAR;
            PG8_LDA(At, 0, 1); PG8_STAGE(PG8_SA(0, 0), a2, voffA);
            PG8_BAR; PG8_WAIT_L(0); PG8_MMA(1, 0, At, B0); PG8_BAR; PG8_SCHED;
            PG8_STAGE(PG8_SB(0, 1), b2 + hstep, voffB);
            PG8_WAIT_V(6); PG8_BAR; PG8_MMA(1, 1, At, B1); PG8_BAR;
            PG8_LDB(B0, 1, 0); PG8_SCHED; PG8_LDA(At, 1, 0); PG8_STAGE(PG8_SA(0, 1), a2 + hstep, voffA);
            PG8_WAIT_L(8); PG8_BAR; PG8_WAIT_L(0); PG8_MMA(0, 0, At, B0); PG8_BAR; PG8_SCHED;
            PG8_LDB(B1, 1, 1); PG8_STAGE(PG8_SB(1, 0), b3, voffB);
            PG8_BAR; PG8_WAIT_L(0); PG8_MMA(0, 1, At, B1); PG8_BAR;
            PG8_LDA(At, 1, 1); PG8_STAGE(PG8_SA(1, 0), a3, voffA);
            PG8_BAR; PG8_WAIT_L(0); PG8_MMA(1, 0, At, B0); PG8_BAR; PG8_SCHED;
            PG8_STAGE(PG8_SB(1, 1), b3 + hstep, voffB);
            PG8_WAIT_V(6); PG8_BAR; PG8_MMA(1, 1, At, B1); PG8_BAR;
            }
        }
        if constexpr (ALIGN_EPI) { if (wr == 0) PG8_BAR; }
        E(acc, cur, wr, wc, fr, fq); S.done(cur);
        if (!has_next) break;
#pragma unroll
        for (int a = 0; a < 2; ++a)
#pragma unroll
            for (int b = 0; b < 2; ++b)
#pragma unroll
                for (int m = 0; m < 4; ++m)
#pragma unroll
                    for (int n = 0; n < 2; ++n) acc[a][b][m][n] = (f32x4){0.f, 0.f, 0.f, 0.f};
        cur = nxt; cA = nA; cB = nB; ++ui;
        if constexpr (ALIGN_EPI) { if (wr == 1) PG8_BAR; }
    }
    PG8_WAIT_V(0);
    if constexpr (!ALIGN_EPI) { if (wr == 0) PG8_BAR; }
    PG8_BAR;
#undef PG8_SA
#undef PG8_SB
#undef PG8_STAGE
#undef PG8_LDA
#undef PG8_LDB
#undef PG8_MMA
#undef PG8_WAIT_V
#undef PG8_WAIT_L
#undef PG8_BAR
#undef PG8_SCHED
}


struct EpiInProj {
    static constexpr bool PERM = false;
    bf16_t *QA, *KA, *VA, *QR, *KR, *VR, *GR; float* out; const f32x2* tabr; const f32x2* tabt;
    template <int TY> __device__ __forceinline__ void run(const f32x4 (&acc)[2][2][4][2], const Unit& u, int wr, int wc, int fr, int fq) const {
        const int cb = (TY <= 2 || TY >= 5) ? (u.pn & 1) * 256 : 0;
#pragma unroll
        for (int ai = 0; ai < 2; ++ai)
#pragma unroll
            for (int m = 0; m < 4; ++m) {
                const int r = u.pm * BM + ai * HALF + wr * 64 + m * 16 + fr;
                const int tp = row_tab(r);
#pragma unroll
                for (int bj = 0; bj < 2; ++bj)
#pragma unroll
                    for (int n = 0; n < 2; ++n) {
                        const int col = cb + bj * HALF + wc * 32 + n * 16 + fq * 4;
                        f32x4 v = acc[ai][bj][m][n];
                        if constexpr (TY == 0 || TY == 1) {
                            if (n == 0 && (wc & 1) == 0) {
                                const f32x2* tb = tabr + tp * 8 + (fq & 1) * 4;
#pragma unroll
                                for (int e = 0; e < 4; ++e) { const float pv = __shfl_xor(v[e], 32); const f32x2 cs = tb[e];
                                    v[e] = (fq < 2) ? (v[e] * cs.x - pv * cs.y) : (v[e] * cs.x + pv * cs.y); }
                            }
                            if constexpr (TY == 0) v = v * QSCALE;
                        }
                        if constexpr (TY == 3 || TY == 4) {
                            const f32x2* tb = tabt + tp * 32 + ((col & 63) >> 1);
                            const f32x2 c0 = tb[0], c1 = tb[1];
                            const float a0 = v[0] * c0.x - v[1] * c0.y, a1 = v[1] * c0.x + v[0] * c0.y, a2 = v[2] * c1.x - v[3] * c1.y, a3 = v[3] * c1.x + v[2] * c1.y;
                            v = (f32x4){a0, a1, a2, a3};
                            if constexpr (TY == 4) v = v * 0.125f;
                        }
                        if constexpr (TY == 6) {
#pragma unroll
                            for (int e = 0; e < 4; ++e) v[e] = v[e] / (1.0f + __builtin_amdgcn_exp2f(-1.4426950408889634f * v[e]));
                        }
                        if constexpr (TY == 1 || TY == 2) {
                            float* o = out + (TY == 1 ? (r < MP ? OFF_KP : OFF_KS) : (r < MP ? OFF_VP : OFF_VS)) + (size_t)(r < MP ? r : r - MP) * 512 + col;
                            *(f32x4*)o = v;
                        }
                        bf16_t* dst; int ld;
                        if constexpr (TY == 0) { dst = QA; ld = 512; } else if constexpr (TY == 1) { dst = KA; ld = 512; } else if constexpr (TY == 2) { dst = VA; ld = 512; }
                        else if constexpr (TY == 3) { dst = QR; ld = 256; } else if constexpr (TY == 4) { dst = KR; ld = 256; } else if constexpr (TY == 5) { dst = VR; ld = 512; } else { dst = GR; ld = 512; }
                        u32x2 w; w.x = cvtpk(v[0], v[1]); w.y = cvtpk(v[2], v[3]);
                        *(u32x2*)(dst + (size_t)r * ld + col) = w;
                    }
            }
    }
    __device__ __forceinline__ void operator()(const f32x4 (&acc)[2][2][4][2], const Unit& u, int wr, int wc, int fr, int fq) const {
        const int pn = u.pn;
        if (pn < 2) run<0>(acc, u, wr, wc, fr, fq);
        else if (pn < 4) run<1>(acc, u, wr, wc, fr, fq);
        else if (pn < 6) run<2>(acc, u, wr, wc, fr, fq);
        else if (pn == 6) run<3>(acc, u, wr, wc, fr, fq);
        else if (pn == 7) run<4>(acc, u, wr, wc, fr, fq);
        else if (pn < 10) run<5>(acc, u, wr, wc, fr, fq);
        else run<6>(acc, u, wr, wc, fr, fq);
    }
};
template <bool FROM_X> struct EpiResid {
    static constexpr bool PERM = false;
    const float* xp; const float* xs; float* dst; const float* gate; int gld;
    __device__ __forceinline__ void operator()(const f32x4 (&acc)[2][2][4][2], const Unit& u, int wr, int wc, int fr, int fq) const {
#pragma unroll
        for (int ai = 0; ai < 2; ++ai)
#pragma unroll
            for (int m = 0; m < 4; ++m) {
                const int r = u.pm * BM + ai * HALF + wr * 64 + m * 16 + fr;
                const float* g = gate + (size_t)row_bidx(r) * gld;
                const float* base = FROM_X ? (r < MP ? xp + (size_t)r * D : xs + (size_t)(r - MP) * D) : dst + (size_t)r * D;
#pragma unroll
                for (int bj = 0; bj < 2; ++bj)
#pragma unroll
                    for (int n = 0; n < 2; ++n) {
                        const int col = u.pn * BM + bj * HALF + wc * 32 + n * 16 + fq * 4;
                        const f32x4 b = *(const f32x4*)(base + col), gg = *(const f32x4*)(g + col);
                        *(f32x4*)(dst + (size_t)r * D + col) = b + gg * acc[ai][bj][m][n];
                    }
            }
    }
};
struct EpiRelu2 {
    static constexpr bool PERM = true;
    bf16_t* O; int ldc;
    __device__ __forceinline__ void operator()(const f32x4 (&acc)[2][2][4][2], const Unit& u, int wr, int wc, int fr, int fq) const {
        const int row0 = u.pm * BM + wr * 64 + fr, col0 = u.pn * BM + wc * 32 + 8 * fq;
#pragma unroll
        for (int ai = 0; ai < 2; ++ai)
#pragma unroll
            for (int m = 0; m < 4; ++m) { bf16_t* rowp = O + (size_t)(row0 + ai * HALF + m * 16) * ldc + col0;
#pragma unroll
                for (int bj = 0; bj < 2; ++bj) { f32x4 v0 = acc[ai][bj][m][0], v1 = acc[ai][bj][m][1];
#pragma unroll
                    for (int e = 0; e < 4; ++e) { const float a = fmaxf(v0[e], 0.f), b = fmaxf(v1[e], 0.f); v0[e] = a * a; v1[e] = b * b; }
                    u32x4 w; w.x = cvtpk(v0[0], v0[1]); w.y = cvtpk(v0[2], v0[3]); w.z = cvtpk(v1[0], v1[1]); w.w = cvtpk(v1[2], v1[3]);
                    *(u32x4*)(rowp + bj * HALF) = w; } }
    }
};
}

struct Args { const float* in[16]; float* out; unsigned char* ws; int ph_lo, ph_hi; };
struct Frame {
    LAS unsigned char* lds;
    int tid, lane, wave, vcu, G;
    const Args* a;
#define FIN(i) ((const float*)F.a->in[i])
#define FWS(T, off) ((T*)(F.a->ws + (off)))
};
#define F_xp FIN(0)
#define F_xs FIN(1)
#define F_cp FIN(2)
#define F_cs FIN(3)
#define F_ck FIN(4)
#define F_cv FIN(5)
#define F_st FIN(6)
#define F_w_ada FIN(7)
#define F_b_ada FIN(8)
#define F_w_in FIN(9)
#define F_gain FIN(10)
#define F_w_out FIN(11)
#define F_w_ff1 FIN(12)
#define F_w_ff2 FIN(13)
#define F_w_adaf FIN(14)
#define F_b_adaf FIN(15)
#define F_out (F.a->out)
#define F_MOD FWS(float, WS_MOD)
#define F_MODF FWS(float, WS_MODF)
#define F_TABR FWS(f32x2, WS_TABR)
#define F_TABT FWS(f32x2, WS_TABT)
#define F_WIN FWS(bf16_t, WS_WIN)
#define F_WOUT FWS(bf16_t, WS_WOUT)
#define F_W1 FWS(bf16_t, WS_W1)
#define F_W2 FWS(bf16_t, WS_W2)
#define F_XN FWS(bf16_t, WS_XN)
#define F_QA FWS(bf16_t, WS_QA)
#define F_KA FWS(bf16_t, WS_KA)
#define F_VA FWS(bf16_t, WS_VA)
#define F_QR FWS(bf16_t, WS_QR)
#define F_KR FWS(bf16_t, WS_KR)
#define F_VR FWS(bf16_t, WS_VR)
#define F_GR FWS(bf16_t, WS_GR)
#define F_MIX FWS(bf16_t, WS_MIX)
#define F_H FWS(bf16_t, WS_H)
#define F_KV FWS(float, WS_KV)
#define F_X1 FWS(float, WS_X1)

__device__ __forceinline__ unsigned f2bf(float f) { unsigned u = __builtin_bit_cast(unsigned, f); return (u + 0x7fffu + ((u >> 16) & 1u)) >> 16; }
__device__ __forceinline__ unsigned pk2(float lo, float hi) { return f2bf(lo) | (f2bf(hi) << 16); }
__device__ __forceinline__ void p0_transpose_item(const float* W, int K, int N, bf16_t* WT, LAS float* scr, int item, int lane) {
    const int nblk = N / 32, kb = item / nblk, nb = item % nblk, k0 = 64 * kb, n0 = 32 * nb;
#pragma unroll 8
    for (int i = 0; i < 32; ++i) { const int kk = 2 * i + (lane >> 5); scr[kk * 33 + (lane & 31)] = W[(size_t)(k0 + kk) * N + n0 + (lane & 31)]; }
    asm volatile("s_waitcnt lgkmcnt(0)" ::: "memory");
    const int c = lane & 7;
#pragma unroll
    for (int j = 0; j < 4; ++j) { const int n = (lane >> 3) + 8 * j; const LAS float* s = scr + (8 * c) * 33 + n;
        u32x4 o; o.x = pk2(s[0 * 33], s[1 * 33]); o.y = pk2(s[2 * 33], s[3 * 33]); o.z = pk2(s[4 * 33], s[5 * 33]); o.w = pk2(s[6 * 33], s[7 * 33]);
        *(u32x4*)(WT + (size_t)(n0 + n) * K + k0 + 8 * c) = o; }
    asm volatile("s_waitcnt lgkmcnt(0)" ::: "memory");
}
__device__ __forceinline__ void sincos_d(double x, float& sn, float& cs) {
    const double k = __builtin_rint(x * 0.63661977236758134308);
    double r = __builtin_fma(-k, 1.57079632679489655800e+00, x); r = __builtin_fma(-k, 6.12323399573676603587e-17, r);
    const double r2 = r * r;
    double s = -7.6471637318198164759e-13; s = s * r2 + 1.6059043836821614599e-10; s = s * r2 - 2.5052108385441718775e-08; s = s * r2 + 2.7557319223985890653e-06;
    s = s * r2 - 1.9841269841269841270e-04; s = s * r2 + 8.3333333333333333333e-03; s = s * r2 - 1.6666666666666666667e-01; s = r + r * r2 * s;
    double c = 4.7794773323873852974e-14; c = c * r2 - 1.1470745597729724714e-11; c = c * r2 + 2.0876756987868098979e-09; c = c * r2 - 2.7557319223985890653e-07;
    c = c * r2 + 2.4801587301587301587e-05; c = c * r2 - 1.3888888888888888889e-03; c = c * r2 + 4.1666666666666666667e-02; c = c * r2 - 0.5; c = 1.0 + r2 * c;
    const int q = ((int)k) & 3;
    const double ss = (q == 0) ? s : (q == 1) ? c : (q == 2) ? -s : -c;
    const double cc = (q == 0) ? c : (q == 1) ? -s : (q == 2) ? -c : s;
    sn = (float)ss; cs = (float)cc;
}
__device__ __forceinline__ void p0_prologue(Frame& F) {
    {
        const int w = F.wave, lane = F.lane, hh = lane >> 5, cl = lane & 31;
        LAS float* sst = (LAS float*)(F.lds + w * 16384);
        for (int item = F.vcu; item < 256; item += F.G) {
            const bool fin = item >= 192; const int col = (fin ? item - 192 : item) * 32 + cl;
            const float* W = fin ? F_w_adaf : F_w_ada; const int ldw = fin ? 2048 : 6144;
            float acc[NMODB];
#pragma unroll
            for (int r = 0; r < NMODB; ++r) acc[r] = 0.f;
            for (int sub = 0; sub < 4; ++sub) {
                const int kb = 128 * w + 16 * sub;
#pragma unroll 4
                for (int i = 0; i < 20; ++i) { const int idx = lane + 64 * i, h2 = idx / 640, rem = idx % 640, r = rem >> 4, kk = rem & 15, k = kb + 64 * h2 + kk;
                    const float c = r < NB ? F_cp[r * D + k] : F_cs[(r - NB) * D + k];
                    sst[idx] = c / (1.0f + __expf(-c)); }
                asm volatile("s_waitcnt lgkmcnt(0)" ::: "memory");
#pragma unroll 1
                for (int k4 = 0; k4 < 4; ++k4) {
                    const int k = kb + 64 * hh + 4 * k4;
                    const float w0 = W[(size_t)(k + 0) * ldw + col], w1 = W[(size_t)(k + 1) * ldw + col], w2 = W[(size_t)(k + 2) * ldw + col], w3 = W[(size_t)(k + 3) * ldw + col];
#pragma unroll
                    for (int r = 0; r < NMODB; ++r) { const f32x4 s4 = *(const LAS f32x4*)(sst + hh * 640 + r * 16 + 4 * k4);
                        acc[r] += s4.x * w0 + s4.y * w1 + s4.z * w2 + s4.w * w3;
                        if ((r & 7) == 7) __builtin_amdgcn_sched_barrier(0); }
                }
                asm volatile("s_waitcnt lgkmcnt(0)" ::: "memory");
            }
            __syncthreads();
            LAS float* red = (LAS float*)F.lds;
#pragma unroll
            for (int r = 0; r < NMODB; ++r) red[((2 * w + hh) * NMODB + r) * 32 + cl] = acc[r];
            __syncthreads();
            for (int o = F.tid; o < NMODB * 32; o += NTHREADS) { const int r = o >> 5, c2 = o & 31; float s = 0.f;
#pragma unroll
                for (int p = 0; p < 16; ++p) s += red[(p * NMODB + r) * 32 + c2];
                const int oc = (fin ? item - 192 : item) * 32 + c2;
                if (fin) F_MODF[r * 2048 + oc] = s + F_b_adaf[oc]; else F_MOD[r * 6144 + oc] = s + F_b_ada[oc]; }
            __syncthreads();
        }
    }
    {
        LAS float* scr = (LAS float*)(F.lds + F.wave * 16384);
        const int gw = F.vcu * NWAVES + F.wave, NGW = F.G * NWAVES;
        constexpr int I_IN = (D / 64) * (NIN / 32), I_O = (D / 64) * (D / 32), I_1 = (D / 64) * (FF / 32), I_2 = (FF / 64) * (D / 32);
        constexpr int NITEMS = I_IN + I_O + I_1 + I_2;
        for (int it = gw; it < NITEMS; it += NGW) {
            int r = it;
            if (r < I_IN) { p0_transpose_item(F_w_in, D, NIN, F_WIN, scr, r, F.lane); continue; } r -= I_IN;
            if (r < I_O) { p0_transpose_item(F_w_out, D, D, F_WOUT, scr, r, F.lane); continue; } r -= I_O;
            if (r < I_1) { p0_transpose_item(F_w_ff1, D, FF, F_W1, scr, r, F.lane); continue; } r -= I_1;
            p0_transpose_item(F_w_ff2, FF, D, F_W2, scr, r, F.lane);
        }
    }
    {
        const int gt = F.vcu * NTHREADS + F.tid, NT = F.G * NTHREADS;
        for (int i = gt; i < 2056 * 40; i += NT) { const int p = i / 40, j = i % 40; const int pos = p < 2048 ? p : 8192 + (p - 2048);
            float sn, cs; sincos_d((double)pos * INVF[j], sn, cs);
            if (j < 8) F_TABR[p * 8 + j] = (f32x2){cs, sn}; else F_TABT[p * 32 + (j - 8)] = (f32x2){cs, sn}; }
    }
}

template <int MODE> __device__ __forceinline__ void norm_rows(Frame& F) {
    const int gw = F.vcu * NWAVES + F.wave, NGW = F.G * NWAVES;
    for (int m = gw; m < M; m += NGW) {
        const float* xrow = MODE == 0 ? (m < MP ? F_xp + (size_t)m * D : F_xs + (size_t)(m - MP) * D) : F_X1 + (size_t)m * D;
        const f32x4* xr = (const f32x4*)xrow + F.lane;
        f32x4 v[4]; float s = 0.f;
#pragma unroll
        for (int j = 0; j < 4; ++j) { v[j] = xr[64 * j]; s += (v[j].x * v[j].x + v[j].y * v[j].y) + (v[j].z * v[j].z + v[j].w * v[j].w); }
        const float rstd = 1.0f / sqrtf(wave_sum(s) * (1.f / D) + EPS);
        const int bi = row_bidx(m);
        const float* shp = MODE == 0 ? F_MOD + (size_t)bi * 6144 : MODE == 1 ? F_MOD + (size_t)bi * 6144 + 3072 : F_MODF + (size_t)bi * 2048;
        const float* scp = shp + 1024;
#pragma unroll
        for (int j = 0; j < 4; ++j) {
            const f32x4 sh = ((const f32x4*)shp)[F.lane + 64 * j], sc = ((const f32x4*)scp)[F.lane + 64 * j];
            const f32x4 o = v[j] * rstd * (sc + 1.0f) + sh;
            if constexpr (MODE == 2) ((f32x4*)(F_out + OFF_Y + (size_t)m * D))[F.lane + 64 * j] = o;
            else { u32x2 w; w.x = cvtpk(o.x, o.y); w.y = cvtpk(o.z, o.w); ((u32x2*)(F_XN + (size_t)m * D))[F.lane + 64 * j] = w; }
        }
    }
}

typedef short v4i16_t __attribute__((ext_vector_type(4)));
template <bool PERMK> __device__ __forceinline__ bf16x8 trfrag(LAS const unsigned char* img, int k0, int lane) {
    const int hi = lane >> 5, gb = (lane >> 4) & 1, q = (lane >> 2) & 3, p = lane & 3;
    const int ra = PERMK ? (k0 + 4 * hi + q) : (k0 + 8 * hi + q), rb = PERMK ? (ra + 8) : (ra + 4);
    LAS const unsigned char* pa = img + ra * 64 + (16 * gb + 4 * p) * 2; LAS const unsigned char* pb = img + rb * 64 + (16 * gb + 4 * p) * 2;
    const s16x4 lo = __builtin_bit_cast(s16x4, __builtin_amdgcn_ds_read_tr16_b64_v4i16((LAS v4i16_t*)pa));
    const s16x4 h4 = __builtin_bit_cast(s16x4, __builtin_amdgcn_ds_read_tr16_b64_v4i16((LAS v4i16_t*)pb));
    return (bf16x8){lo[0], lo[1], lo[2], lo[3], h4[0], h4[1], h4[2], h4[3]};
}
__device__ __forceinline__ bf16x8 pack8(float a0, float a1, float a2, float a3, float a4, float a5, float a6, float a7) {
    u32x4 w; w.x = cvtpk(a0, a1); w.y = cvtpk(a2, a3); w.z = cvtpk(a4, a5); w.w = cvtpk(a6, a7); return __builtin_bit_cast(bf16x8, w);
}
__device__ __forceinline__ bf16x8 ld8_bf16(const bf16_t* p) { return *(const bf16x8*)p; }
__device__ __forceinline__ bf16x8 ld8_f32(const float* p) { const f32x4 a = *(const f32x4*)p, b = *(const f32x4*)(p + 4); return pack8(a.x, a.y, a.z, a.w, b.x, b.y, b.z, b.w); }

struct AttnAcc { f32x16 o0, o1; float m, l; };
template <int BR, bool EXCL, bool QMASK>
__device__ __forceinline__ void attn_step(AttnAcc& A, const bf16x8 (&kf)[4], const bf16x8 (&qf)[4], LAS const unsigned char* vimg, int qp, bool qvalid, int p0, int s_hi, int s_lo, int lane) {
    const int hi = lane >> 5;
    f32x16 s = {0.f, 0.f, 0.f, 0.f, 0.f, 0.f, 0.f, 0.f, 0.f, 0.f, 0.f, 0.f, 0.f, 0.f, 0.f, 0.f};
#pragma unroll
    for (int d0 = 0; d0 < 4; ++d0) s = __builtin_amdgcn_mfma_f32_32x32x16_bf16(kf[d0], qf[d0], s, 0, 0, 0);
    const int pbase = p0 + 4 * hi * s_lo, dbase = qp - pbase;
    float mu[16]; float tmax = -1e30f;
#pragma unroll
    for (int r = 0; r < 16; ++r) {
        const int off = (r >> 2) * s_hi + (r & 3) * s_lo, dist = dbase - off, pos = pbase + off;
        int ml = 0;
        if (BR & 1) ml += (dist <= 128) ? 1 : 0;
        if (BR & 2) ml += ((dist & 3) == 0 && dist <= 512) ? 1 : 0;
        if (BR & 4) ml += ((dist & 15) == 0 && dist <= 2048) ? 1 : 0;
        if (EXCL && (dist & 15) == 0) ml = 0;
        if (dist < 0 || pos < 0) ml = 0;
        if (QMASK && !qvalid) ml = 0;
        mu[r] = (float)ml;
        s[r] = ml ? s[r] : -1e30f; tmax = fmaxf(tmax, s[r]);
    }
    tmax = fmaxf(tmax, __shfl_xor(tmax, 32));
    const float mn = fmaxf(A.m, tmax), alpha = __builtin_amdgcn_exp2f(A.m - mn); A.m = mn;
    float ps = 0.f;
#pragma unroll
    for (int r = 0; r < 16; ++r) { s[r] = mu[r] * __builtin_amdgcn_exp2f(s[r] - mn); ps += s[r]; }
    A.l = A.l * alpha + ps;
    A.o0 = A.o0 * alpha; A.o1 = A.o1 * alpha;
    const bf16x8 pf0 = pack8(s[0], s[1], s[2], s[3], s[4], s[5], s[6], s[7]), pf1 = pack8(s[8], s[9], s[10], s[11], s[12], s[13], s[14], s[15]);
    A.o0 = __builtin_amdgcn_mfma_f32_32x32x16_bf16(trfrag<true>(vimg, 0, lane), pf0, A.o0, 0, 0, 0);
    A.o0 = __builtin_amdgcn_mfma_f32_32x32x16_bf16(trfrag<true>(vimg, 16, lane), pf1, A.o0, 0, 0, 0);
    A.o1 = __builtin_amdgcn_mfma_f32_32x32x16_bf16(trfrag<true>(vimg + 2048, 0, lane), pf0, A.o1, 0, 0, 0);
    A.o1 = __builtin_amdgcn_mfma_f32_32x32x16_bf16(trfrag<true>(vimg + 2048, 16, lane), pf1, A.o1, 0, 0, 0);
}
template <bool F32SRC> struct TileRegs { bf16x8 kf[4]; bf16x8 vs[4]; };
template <bool F32SRC> __device__ __forceinline__ void tile_load(TileRegs<F32SRC>& T, const void* kb, const void* vb, long rowbase, int pmax, int p0, int s_hi, int s_lo, int lane) {
    const int r32 = lane & 31, hi = lane >> 5;
    int pk = p0 + (r32 >> 3) * s_hi + (r32 & 7) * s_lo; pk = pk < 0 ? 0 : (pk > pmax ? pmax : pk);
    const int kv = lane >> 1; int pv = p0 + (kv >> 3) * s_hi + (kv & 7) * s_lo; pv = pv < 0 ? 0 : (pv > pmax ? pmax : pv);
    if constexpr (F32SRC) {
        const float* kr = (const float*)kb + (rowbase + pk) * 512 + 8 * hi; const float* vr = (const float*)vb + (rowbase + pv) * 512 + 32 * (lane & 1);
#pragma unroll
        for (int d0 = 0; d0 < 4; ++d0) T.kf[d0] = ld8_f32(kr + 16 * d0);
#pragma unroll
        for (int j = 0; j < 4; ++j) T.vs[j] = ld8_f32(vr + 8 * j);
    } else {
        const bf16_t* kr = (const bf16_t*)kb + (rowbase + pk) * 512 + 8 * hi; const bf16_t* vr = (const bf16_t*)vb + (rowbase + pv) * 512 + 32 * (lane & 1);
#pragma unroll
        for (int d0 = 0; d0 < 4; ++d0) T.kf[d0] = ld8_bf16(kr + 16 * d0);
#pragma unroll
        for (int j = 0; j < 4; ++j) T.vs[j] = ld8_bf16(vr + 8 * j);
    }
}
template <bool F32SRC> __device__ __forceinline__ void tile_stage_v(const TileRegs<F32SRC>& T, LAS unsigned char* vimg, int lane) {
    LAS unsigned char* d = vimg + (lane & 1) * 2048 + (lane >> 1) * 64;
#pragma unroll
    for (int j = 0; j < 4; ++j) *(LAS bf16x8*)(d + 16 * j) = T.vs[j];
}
__device__ __forceinline__ void attn_store(const AttnAcc& A, bf16_t* mixrow, int lane) {
    const int hi = lane >> 5;
    const float lt = A.l + __shfl_xor(A.l, 32), inv = 1.0f / lt;
#pragma unroll
    for (int g = 0; g < 4; ++g) {
        u32x2 w0, w1; w0.x = cvtpk(A.o0[4 * g] * inv, A.o0[4 * g + 1] * inv); w0.y = cvtpk(A.o0[4 * g + 2] * inv, A.o0[4 * g + 3] * inv);
        w1.x = cvtpk(A.o1[4 * g] * inv, A.o1[4 * g + 1] * inv); w1.y = cvtpk(A.o1[4 * g + 2] * inv, A.o1[4 * g + 3] * inv);
        *(u32x2*)(mixrow + 8 * g + 4 * hi) = w0; *(u32x2*)(mixrow + 32 + 8 * g + 4 * hi) = w1;
    }
}
#define WAVE_LDS_FENCE() asm volatile("s_waitcnt lgkmcnt(0)" ::: "memory")

__device__ __forceinline__ void prompt_attn_tile(Frame& F, int b, int h, int rho, int c, LAS unsigned char* vimg) {
    const int lane = F.lane, r32 = lane & 31, hi = lane >> 5;
    const int T0 = 512 * c + rho, qp = T0 + 16 * r32;
    const long rowbase = (long)b * SEQ;
    const bf16_t* Qp = F_QA + h * 64; const bf16_t* Kp = F_KA + h * 64; const bf16_t* Vp = F_VA + h * 64;
    bf16x8 qf[4];
#pragma unroll
    for (int d0 = 0; d0 < 4; ++d0) qf[d0] = ld8_bf16(Qp + (rowbase + qp) * 512 + 16 * d0 + 8 * hi);
    AttnAcc A; A.m = -1e30f; A.l = 0.f;
#pragma unroll
    for (int r = 0; r < 16; ++r) { A.o0[r] = 0.f; A.o1[r] = 0.f; }
    TileRegs<false> T;
    for (int ti = 0; ti < 5; ++ti) { const int p0 = T0 - 2048 + 512 * ti; if (p0 + 496 < 0) continue;
        tile_load<false>(T, Kp, Vp, rowbase, SEQ - 1, p0, 128, 16, lane); tile_stage_v<false>(T, vimg, lane); WAVE_LDS_FENCE();
        attn_step<7, false, false>(A, T.kf, qf, vimg, qp, true, p0, 128, 16, lane); WAVE_LDS_FENCE(); }
    for (int ti = 0; ti < 3; ++ti) { const int p0 = T0 - 512 + 128 * ti; if (p0 + 124 < 0) continue;
        tile_load<false>(T, Kp, Vp, rowbase, SEQ - 1, p0, 32, 4, lane); tile_stage_v<false>(T, vimg, lane); WAVE_LDS_FENCE();
        attn_step<7, true, false>(A, T.kf, qf, vimg, qp, true, p0, 32, 4, lane); WAVE_LDS_FENCE(); }
    for (int ti = 0; ti < 20; ++ti) { const int p0 = T0 - 128 + 32 * ti; if (p0 + 31 < 0 || p0 > SEQ - 1) continue;
        tile_load<false>(T, Kp, Vp, rowbase, SEQ - 1, p0, 8, 1, lane); tile_stage_v<false>(T, vimg, lane); WAVE_LDS_FENCE();
        attn_step<7, true, false>(A, T.kf, qf, vimg, qp, true, p0, 8, 1, lane); WAVE_LDS_FENCE(); }
    attn_store(A, F_MIX + (rowbase + qp) * D + h * 64, lane);
}

__device__ __forceinline__ void sample_attn_item(Frame& F, int sb, int h) {
    const int lane = F.lane, r32 = lane & 31, hi = lane >> 5, w = F.wave;
    LAS unsigned char* vimg = F.lds + w * 4096;
    const bool qvalid = r32 < DT; const int qp = LCACHE + (qvalid ? r32 : 0);
    bf16x8 qf[4];
#pragma unroll
    for (int d0 = 0; d0 < 4; ++d0) qf[d0] = ld8_bf16(F_QA + (size_t)(MP + sb * DT + (qvalid ? r32 : 0)) * 512 + h * 64 + 16 * d0 + 8 * hi);
    AttnAcc A; A.m = -1e30f; A.l = 0.f;
#pragma unroll
    for (int r = 0; r < 16; ++r) { A.o0[r] = 0.f; A.o1[r] = 0.f; }
    for (int ti = w; ti < 41; ti += NWAVES) {
        if (ti == 0) {
            TileRegs<false> T; tile_load<false>(T, F_KA + h * 64, F_VA + h * 64, (long)(MP + sb * DT) - LCACHE, LCACHE + DT - 1, LCACHE, 8, 1, lane);
            tile_stage_v<false>(T, vimg, lane); WAVE_LDS_FENCE();
            attn_step<7, false, true>(A, T.kf, qf, vimg, qp, qvalid, LCACHE, 8, 1, lane); WAVE_LDS_FENCE();
        } else {
            const int p0 = ti <= 16 ? (LCACHE - 512 + 32 * (ti - 1)) : 64 * (ti - 17); const int s_hi = ti <= 16 ? 8 : 16;
            TileRegs<true> T; tile_load<true>(T, F_ck + h * 64, F_cv + h * 64, (long)sb * LCACHE, LCACHE - 1, p0, s_hi, 1, lane);
            tile_stage_v<true>(T, vimg, lane); WAVE_LDS_FENCE();
            attn_step<7, false, true>(A, T.kf, qf, vimg, qp, qvalid, p0, s_hi, 1, lane); WAVE_LDS_FENCE();
        }
    }
    LAS float* po = (LAS float*)(F.lds + 32768); LAS float* pm = po + 8 * 8 * 64; LAS float* pl = pm + 64;
    const float lt = A.l + __shfl_xor(A.l, 32);
    if (qvalid) {
#pragma unroll
        for (int g = 0; g < 4; ++g) {
            *(LAS f32x4*)(po + (w * 8 + r32) * 64 + 8 * g + 4 * hi) = (f32x4){A.o0[4 * g], A.o0[4 * g + 1], A.o0[4 * g + 2], A.o0[4 * g + 3]};
            *(LAS f32x4*)(po + (w * 8 + r32) * 64 + 32 + 8 * g + 4 * hi) = (f32x4){A.o1[4 * g], A.o1[4 * g + 1], A.o1[4 * g + 2], A.o1[4 * g + 3]};
        }
        if (hi == 0) { pm[w * 8 + r32] = A.m; pl[w * 8 + r32] = lt; }
    }
    __syncthreads();
    {
        const int q = F.tid >> 6, d = F.tid & 63;
        float mm = -1e30f;
#pragma unroll
        for (int ww = 0; ww < 8; ++ww) mm = fmaxf(mm, pm[ww * 8 + q]);
        float L = 0.f, O = 0.f;
#pragma unroll
        for (int ww = 0; ww < 8; ++ww) { const float f = __builtin_amdgcn_exp2f(pm[ww * 8 + q] - mm); L += pl[ww * 8 + q] * f; O += po[(ww * 8 + q) * 64 + d] * f; }
        const float o = O / L;
        F_MIX[(size_t)(MP + sb * DT + q) * D + h * 64 + d] = (bf16_t)f2bf(o);
    }
    __syncthreads();
}

__device__ __forceinline__ void ret_kv_item(Frame& F, int b, int h, int j) {
    const int tid = F.tid, lane = F.lane, w = F.wave;
    LAS unsigned char* kimg = F.lds;
    LAS unsigned char* vimg = F.lds + 16384;
    const size_t R0 = (size_t)b * SEQ + (size_t)j * 128;
    const float lg = log2g_of(h);
#pragma unroll
    for (int i = 0; i < 2; ++i) { const int id = tid + NTHREADS * i, row = id >> 3, ch = id & 7;
        const bf16x8 v = *(const bf16x8*)(F_KR + (R0 + row) * 256 + h * 64 + 8 * ch);
        *(LAS bf16x8*)(kimg + (ch >> 2) * 8192 + row * 64 + (ch & 3) * 16) = v; }
#pragma unroll
    for (int i = 0; i < 4; ++i) { const int id = tid + NTHREADS * i, row = id >> 4, ch = id & 15;
        const u32x4 v = *(const u32x4*)(F_VR + (R0 + row) * 512 + h * 128 + 8 * ch);
        const float sc = __builtin_amdgcn_exp2f((float)(127 - row) * lg);
        u32x4 o; o.x = cvtpk(bflo(v.x) * sc, bfhi(v.x) * sc); o.y = cvtpk(bflo(v.y) * sc, bfhi(v.y) * sc); o.z = cvtpk(bflo(v.z) * sc, bfhi(v.z) * sc); o.w = cvtpk(bflo(v.w) * sc, bfhi(v.w) * sc);
        *(LAS u32x4*)(vimg + (ch >> 2) * 8192 + row * 64 + (ch & 3) * 16) = o; }
    __syncthreads();
    const int db = w >> 2, eb = w & 3;
    f32x16 acc;
#pragma unroll
    for (int r = 0; r < 16; ++r) acc[r] = 0.f;
#pragma unroll
    for (int s = 0; s < 8; ++s)
        acc = __builtin_amdgcn_mfma_f32_32x32x16_bf16(trfrag<false>(kimg + db * 8192, 16 * s, lane), trfrag<false>(vimg + eb * 8192, 16 * s, lane), acc, 0, 0, 0);
    float* kvo = F_KV + ((size_t)((b * 4 + h) * 16 + j)) * 8192;
    const int r32 = lane & 31, hi = lane >> 5;
#pragma unroll
    for (int r = 0; r < 16; ++r) { const int d = 32 * db + (r & 3) + 8 * (r >> 2) + 4 * hi; kvo[d * 128 + 32 * eb + r32] = acc[r]; }
    __syncthreads();
}
__device__ __forceinline__ void ret_out_item(Frame& F, int b, int h, int c) {
    const int tid = F.tid, lane = F.lane, w = F.wave, r32 = lane & 31, hi = lane >> 5;
    LAS unsigned char* vimg = F.lds;
    LAS unsigned char* simg = F.lds + 32768;
    LAS float* stat = (LAS float*)(F.lds + 49152);
    const size_t R0 = (size_t)b * SEQ + (size_t)c * 128;
    const float lg = log2g_of(h), gam = __builtin_amdgcn_exp2f(128.f * lg);
#pragma unroll
    for (int i = 0; i < 4; ++i) { const int id = tid + NTHREADS * i, row = id >> 4, ch = id & 15;
        const bf16x8 v = *(const bf16x8*)(F_VR + (R0 + row) * 512 + h * 128 + 8 * ch);
        *(LAS bf16x8*)(vimg + (ch >> 2) * 8192 + row * 64 + (ch & 3) * 16) = v; }
    {
        const float* kvb = F_KV + (size_t)((b * 4 + h) * 16) * 8192;
        f32x4 S[4];
#pragma unroll
        for (int i = 0; i < 4; ++i) S[i] = (f32x4){0.f, 0.f, 0.f, 0.f};
        for (int j = 0; j < c; ++j) {
#pragma unroll
            for (int i = 0; i < 4; ++i) S[i] = S[i] * gam + *(const f32x4*)(kvb + (size_t)j * 8192 + 4 * (tid + NTHREADS * i));
        }
#pragma unroll
        for (int i = 0; i < 4; ++i) { const int gi = tid + NTHREADS * i, d = gi >> 5, e0 = (gi & 31) * 4;
            u32x2 o; o.x = cvtpk(S[i].x, S[i].y); o.y = cvtpk(S[i].z, S[i].w);
            *(LAS u32x2*)(simg + (e0 >> 5) * 4096 + d * 64 + (e0 & 31) * 2) = o; }
        if (c == 15) {
            float* rp = F_out + OFF_RP + (size_t)(b * 4 + h) * 8192;
#pragma unroll
            for (int i = 0; i < 4; ++i) { const f32x4 fin = S[i] * gam + *(const f32x4*)(kvb + (size_t)15 * 8192 + 4 * (tid + NTHREADS * i)); *(f32x4*)(rp + 4 * (tid + NTHREADS * i)) = fin; }
        }
    }
    __syncthreads();
    const int wq = w >> 1, we = w & 1;
    const int q = 32 * wq + r32;
    bf16x8 qf[4];
#pragma unroll
    for (int s = 0; s < 4; ++s) qf[s] = ld8_bf16(F_QR + (R0 + q) * 256 + h * 64 + 16 * s + 8 * hi);
    f32x16 o[2];
#pragma unroll
    for (int r = 0; r < 16; ++r) { o[0][r] = 0.f; o[1][r] = 0.f; }
#pragma unroll
    for (int eb = 0; eb < 2; ++eb)
#pragma unroll
        for (int s = 0; s < 4; ++s) o[eb] = __builtin_amdgcn_mfma_f32_32x32x16_bf16(trfrag<false>(simg + (2 * we + eb) * 4096, 16 * s, lane), qf[s], o[eb], 0, 0, 0);
    { const float gq = __builtin_amdgcn_exp2f((float)(q + 1) * lg); o[0] = o[0] * gq; o[1] = o[1] * gq; }
    for (int jb = 0; jb <= wq; ++jb) {
        bf16x8 kf[4];
#pragma unroll
        for (int s = 0; s < 4; ++s) kf[s] = ld8_bf16(F_KR + (R0 + 32 * jb + r32) * 256 + h * 64 + 16 * s + 8 * hi);
        f32x16 st;
#pragma unroll
        for (int r = 0; r < 16; ++r) st[r] = 0.f;
#pragma unroll
        for (int s = 0; s < 4; ++s) st = __builtin_amdgcn_mfma_f32_32x32x16_bf16(kf[s], qf[s], st, 0, 0, 0);
#pragma unroll
        for (int r = 0; r < 16; ++r) { const int key = 32 * jb + (r & 3) + 8 * (r >> 2) + 4 * hi, dl = q - key;
            st[r] = dl >= 0 ? st[r] * __builtin_amdgcn_exp2f((float)dl * lg) : 0.f; }
        const bf16x8 pf0 = pack8(st[0], st[1], st[2], st[3], st[4], st[5], st[6], st[7]), pf1 = pack8(st[8], st[9], st[10], st[11], st[12], st[13], st[14], st[15]);
#pragma unroll
        for (int eb = 0; eb < 2; ++eb) {
            o[eb] = __builtin_amdgcn_mfma_f32_32x32x16_bf16(trfrag<true>(vimg + (2 * we + eb) * 8192, 32 * jb, lane), pf0, o[eb], 0, 0, 0);
            o[eb] = __builtin_amdgcn_mfma_f32_32x32x16_bf16(trfrag<true>(vimg + (2 * we + eb) * 8192, 32 * jb + 16, lane), pf1, o[eb], 0, 0, 0);
        }
    }
    float sm = 0.f, sq = 0.f;
#pragma unroll
    for (int r = 0; r < 16; ++r) { sm += o[0][r] + o[1][r]; sq += o[0][r] * o[0][r] + o[1][r] * o[1][r]; }
    sm += __shfl_xor(sm, 32); sq += __shfl_xor(sq, 32);
    if (hi == 0) { stat[(w * 32 + r32) * 2] = sm; stat[(w * 32 + r32) * 2 + 1] = sq; }
    __syncthreads();
    sm += stat[((w ^ 1) * 32 + r32) * 2]; sq += stat[((w ^ 1) * 32 + r32) * 2 + 1];
    const float mean = sm * (1.f / 128.f), var = sq * (1.f / 128.f) - mean * mean, rstd = 1.0f / sqrtf(fmaxf(var, 0.f) + EPS);
    const size_t grow = (R0 + q);
#pragma unroll
    for (int eb = 0; eb < 2; ++eb)
#pragma unroll
        for (int g = 0; g < 4; ++g) {
            const int e = 64 * we + 32 * eb + 8 * g + 4 * hi;
            const f32x4 gn = *(const f32x4*)(F_gain + h * 128 + e);
            const u32x2 sg = *(const u32x2*)(F_GR + grow * 512 + h * 128 + e);
            const float y0 = (o[eb][4 * g] - mean) * rstd * gn.x * bflo(sg.x), y1 = (o[eb][4 * g + 1] - mean) * rstd * gn.y * bfhi(sg.x);
            const float y2 = (o[eb][4 * g + 2] - mean) * rstd * gn.z * bflo(sg.y), y3 = (o[eb][4 * g + 3] - mean) * rstd * gn.w * bfhi(sg.y);
            u32x2 wv; wv.x = cvtpk(y0, y1); wv.y = cvtpk(y2, y3);
            *(u32x2*)(F_MIX + grow * D + 512 + h * 128 + e) = wv;
        }
    __syncthreads();
}
__device__ __forceinline__ void ret_sample_item(Frame& F, int sb, int h) {
    const int tid = F.tid;
    LAS float* q = (LAS float*)F.lds;
    LAS float* k = q + 512;
    LAS float* v = k + 512;
    LAS float* sg = v + 1024;
    LAS float* sc = sg + 1024;
    LAS float* ob = sc + 64;
    const size_t R0 = (size_t)MP + (size_t)sb * DT;
    const float lg = log2g_of(h);
    { const int i = tid >> 6, d = tid & 63; q[tid] = bf2f(F_QR[(R0 + i) * 256 + h * 64 + d]); k[tid] = bf2f(F_KR[(R0 + i) * 256 + h * 64 + d]); }
#pragma unroll
    for (int x = 0; x < 2; ++x) { const int id = tid + NTHREADS * x, i = id >> 7, e = id & 127; v[id] = bf2f(F_VR[(R0 + i) * 512 + h * 128 + e]); sg[id] = bf2f(F_GR[(R0 + i) * 512 + h * 128 + e]); }
    __syncthreads();
    if (tid < 64) { const int i = tid >> 3, j = tid & 7; float s = 0.f;
        for (int d = 0; d < 64; ++d) s += q[i * 64 + d] * k[j * 64 + d];
        sc[tid] = (i >= j) ? s * __builtin_amdgcn_exp2f((float)(i - j) * lg) : 0.f; }
    __syncthreads();
    const float* st0 = F_st + (size_t)(sb * 4 + h) * 8192;
    {
        const int e = tid & 127, ih = tid >> 7;
        float c0 = 0.f, c1 = 0.f;
        for (int d = 0; d < 64; ++d) { const float s0 = st0[d * 128 + e]; c0 += q[ih * 64 + d] * s0; c1 += q[(ih + 4) * 64 + d] * s0; }
        float i0 = 0.f, i1 = 0.f;
#pragma unroll
        for (int j = 0; j < 8; ++j) { i0 += sc[ih * 8 + j] * v[j * 128 + e]; i1 += sc[(ih + 4) * 8 + j] * v[j * 128 + e]; }
        ob[ih * 128 + e] = i0 + c0 * __builtin_amdgcn_exp2f((float)(ih + 1) * lg);
        ob[(ih + 4) * 128 + e] = i1 + c1 * __builtin_amdgcn_exp2f((float)(ih + 5) * lg);
    }
    {
        float* rs = F_out + OFF_RS + (size_t)(sb * 4 + h) * 8192; const float g8 = __builtin_amdgcn_exp2f(8.f * lg);
#pragma unroll
        for (int x = 0; x < 4; ++x) { const int gi = tid + NTHREADS * x, d = gi >> 5, e0 = (gi & 31) * 4;
            f32x4 s = *(const f32x4*)(st0 + d * 128 + e0) * g8;
#pragma unroll
            for (int j = 0; j < 8; ++j) { const float kd = k[j * 64 + d] * __builtin_amdgcn_exp2f((float)(7 - j) * lg); const f32x4 vv = *(const LAS f32x4*)(v + j * 128 + e0); s = s + vv * kd; }
            *(f32x4*)(rs + d * 128 + e0) = s; }
    }
    __syncthreads();
    { const int i = F.wave, lane = F.lane;
        const float a = ob[i * 128 + lane], b2 = ob[i * 128 + 64 + lane];
        const float mean = wave_sum(a + b2) * (1.f / 128.f);
        const float da = a - mean, db = b2 - mean; const float var = wave_sum(da * da + db * db) * (1.f / 128.f), rstd = 1.0f / sqrtf(var + EPS);
        bf16_t* mr = F_MIX + (R0 + i) * D + 512 + h * 128;
        mr[lane] = (bf16_t)f2bf(da * rstd * F_gain[h * 128 + lane] * sg[i * 128 + lane]);
        mr[64 + lane] = (bf16_t)f2bf(db * rstd * F_gain[h * 128 + 64 + lane] * sg[i * 128 + 64 + lane]); }
    __syncthreads();
}

constexpr int N_PHASES = 10;
__global__ void __launch_bounds__(NTHREADS, 2) fwd_kernel(Args args) {
    extern __shared__ __attribute__((aligned(16))) unsigned char lds_raw[];
    Frame F;
    F.lds = (LAS unsigned char*)lds_raw;
    F.tid = threadIdx.x; F.lane = F.tid & 63; F.wave = __builtin_amdgcn_readfirstlane(F.tid >> 6);
    F.G = gridDim.x; { const int bx = blockIdx.x; F.vcu = (F.G % 8 == 0) ? (bx % 8) * (F.G / 8) + bx / 8 : bx; }
    F.a = &args;
    const int lo = args.ph_lo, hi = args.ph_hi;
#ifndef PH_MASK
#define PH_MASK 0x3ff
#endif
#define IN(k) ((((PH_MASK) >> (k)) & 1) && lo <= (k) && (k) < hi)
#if MK_MULTI
#define SEAM(k) do { } while (0)
#else
    cg::grid_group grid = cg::this_grid();
#define SEAM(k) do { if (IN(k) && IN((k) + 1)) grid.sync(); } while (0)
#endif
    if (IN(0)) p0_prologue(F);
    SEAM(0);
    if (IN(1)) norm_rows<0>(F);
    SEAM(1);
    if (IN(2)) {
        pg8::Gemm g{F_XN, F_WIN, M, NIN, D}; pg8::StaticOrder S; S.init(M, NIN, F.G, (int)blockIdx.x);
        pg8::EpiInProj E{F_QA, F_KA, F_VA, F_QR, F_KR, F_VR, F_GR, F_out, F_TABR, F_TABT};
        pg8::gemm_phase<pg8::EpiInProj, pg8::StaticOrder, true, true>(F.lds, g, S, E);
    }
    SEAM(2);
    if (IN(3)) {
        for (int it = 0; it < 2; ++it) {
            const int bh = F.vcu >> 2, qq = F.vcu & 3, rh = qq & 1, c = (qq >> 1) == 0 ? (it == 0 ? 0 : 3) : (it == 0 ? 1 : 2);
            if (F.vcu < 256) prompt_attn_tile(F, bh >> 3, bh & 7, 8 * rh + F.wave, c, F.lds + F.wave * 4096);
        }
        __syncthreads();
        for (int it = F.vcu; it < 512; it += F.G) ret_kv_item(F, it >> 6, (it >> 4) & 3, it & 15);
    }
    SEAM(3);
    if (IN(4)) {
        for (int it = F.vcu; it < 256; it += F.G) { const int bh = it >> 3, qq = it & 7;
            ret_out_item(F, bh >> 2, bh & 3, qq); ret_out_item(F, bh >> 2, bh & 3, 15 - qq); }
        for (int it = F.vcu; it < 256; it += F.G) sample_attn_item(F, it >> 3, it & 7);
        for (int it = F.vcu; it < 128; it += F.G) ret_sample_item(F, it >> 2, it & 3);
    }
    SEAM(4);
    if (IN(5)) {
        pg8::Gemm g{F_MIX, F_WOUT, M, D, D}; pg8::StaticOrder S; S.init(M, D, F.G, (int)blockIdx.x);
        pg8::EpiResid<true> E{F_xp, F_xs, F_X1, F_MOD + 2048, 6144};
        pg8::gemm_phase<pg8::EpiResid<true>, pg8::StaticOrder, true, true>(F.lds, g, S, E);
    }
    SEAM(5);
    if (IN(6)) norm_rows<1>(F);
    SEAM(6);
    if (IN(7)) {
        pg8::Gemm g{F_XN, F_W1, M, FF, D}; pg8::StaticOrder S; S.init(M, FF, F.G, (int)blockIdx.x);
        pg8::EpiRelu2 E{F_H, FF};
        pg8::gemm_phase<pg8::EpiRelu2, pg8::StaticOrder, true, true>(F.lds, g, S, E);
    }
    SEAM(7);
    if (IN(8)) {
        pg8::Gemm g{F_H, F_W2, M, D, FF}; pg8::StaticOrder S; S.init(M, D, F.G, (int)blockIdx.x);
        pg8::EpiResid<false> E{nullptr, nullptr, F_X1, F_MOD + 5120, 6144};
        pg8::gemm_phase<pg8::EpiResid<false>, pg8::StaticOrder, true, true>(F.lds, g, S, E);
    }
    SEAM(8);
    if (IN(9)) norm_rows<2>(F);
#undef IN
#undef SEAM
}

extern "C" void kernel_launch(void* const* d_in, const int* in_sizes, int n_in, void* d_out, int out_size, void* d_ws, size_t ws_size, hipStream_t stream) {
    static int grid = 0;
    if (grid == 0) {
        if (n_in != 16 || out_size != OUT_TOTAL || ws_size < WS_END) { fprintf(stderr, "kernel_launch: unexpected problem shape (n_in %d out %d ws %zu)\n", n_in, out_size, ws_size); grid = -1; return; }
        int dev = 0, cus = 0, per_cu = 0;
        if (hipGetDevice(&dev) != hipSuccess || hipDeviceGetAttribute(&cus, hipDeviceAttributeMultiprocessorCount, dev) != hipSuccess) { grid = -1; return; }
        if (hipFuncSetAttribute((const void*)fwd_kernel, hipFuncAttributeMaxDynamicSharedMemorySize, LDS_BYTES) != hipSuccess) { fprintf(stderr, "kernel_launch: hipFuncSetAttribute failed\n"); grid = -1; return; }
        if (hipOccupancyMaxActiveBlocksPerMultiprocessor(&per_cu, (const void*)fwd_kernel, NTHREADS, LDS_BYTES) != hipSuccess || per_cu < 1) { fprintf(stderr, "kernel_launch: occupancy query says %d\n", per_cu); per_cu = 1; }
        (void)hipGetLastError();
        grid = cus;
        if (grid > cus * per_cu) grid = cus * per_cu;
        if (grid != 256) fprintf(stderr, "kernel_launch: note: grid %d\n", grid);
    }
    if (grid < 0) return;
    Args a{};
    for (int i = 0; i < 16; ++i) a.in[i] = (const float*)d_in[i];
    a.out = (float*)d_out; a.ws = (unsigned char*)d_ws;
#if MK_MULTI
    for (int p = 0; p < N_PHASES; ++p) { a.ph_lo = p; a.ph_hi = p + 1; hipLaunchKernelGGL(fwd_kernel, dim3(grid), dim3(NTHREADS), LDS_BYTES, stream, a); }
#else
    a.ph_lo = 0; a.ph_hi = N_PHASES;
    void* kargs[] = {&a};
    hipError_t e = hipLaunchCooperativeKernel((const void*)fwd_kernel, dim3(grid), dim3(NTHREADS), kargs, LDS_BYTES, stream);
    if (e != hipSuccess) fprintf(stderr, "kernel_launch: cooperative launch failed: %s (grid %d)\n", hipGetErrorString(e), grid);
#endif
}
```

```cpp
#include <hip/hip_runtime.h>
#include <hip/hip_cooperative_groups.h>
#include <cstdio>
#include <cstdint>
namespace cg = cooperative_groups;

#ifndef MK_USE_CG
#define MK_USE_CG 0
#endif
#ifndef MK_MULTI
#define MK_MULTI 0
#endif

#define LAS __attribute__((address_space(3)))
#define GAS __attribute__((address_space(1)))
typedef unsigned short bf16_t;
typedef short bf16x8 __attribute__((ext_vector_type(8)));
typedef short s16x4 __attribute__((ext_vector_type(4)));
typedef float f32x2 __attribute__((ext_vector_type(2)));
typedef float f32x4 __attribute__((ext_vector_type(4)));
typedef float f32x16 __attribute__((ext_vector_type(16)));
typedef unsigned u32x2 __attribute__((ext_vector_type(2)));
typedef unsigned u32x4 __attribute__((ext_vector_type(4)));
typedef __bf16 bf16x2_t __attribute__((ext_vector_type(2)));

constexpr int D = 1024, SEQ = 2048, NB = 8, DBT = 32, DT = 8;
constexpr int MP = NB * SEQ, MS = DBT * DT, M = MP + MS;
constexpr int NIN = 3072, FF = 4096, NMODB = NB + DBT;
constexpr int LCACHE = 2048;
constexpr float EPS = 1e-6f;
constexpr float QSCALE = 0.125f * 1.4426950408889634f;
constexpr size_t OFF_Y = 0, OFF_KP = 17039360, OFF_VP = 25427968, OFF_RP = 33816576, OFF_KS = 34078720, OFF_VS = 34209792, OFF_RS = 34340864;
constexpr int OUT_TOTAL = 35389440;

constexpr size_t MiB = 1u << 20;
constexpr size_t WS_CTL = 0;
constexpr size_t WS_MOD = 1 * MiB;
constexpr size_t WS_MODF = WS_MOD + (size_t)NMODB * 6144 * 4;
constexpr size_t WS_TABR = 3 * MiB;
constexpr size_t WS_TABT = WS_TABR + 2056 * 8 * 8;
constexpr size_t WS_WIN = 4 * MiB;
constexpr size_t WS_WOUT = 10 * MiB;
constexpr size_t WS_W1 = 12 * MiB;
constexpr size_t WS_W2 = 20 * MiB;
constexpr size_t WS_XN = 28 * MiB;
constexpr size_t WS_QA = 61 * MiB;
constexpr size_t WS_KA = 78 * MiB;
constexpr size_t WS_VA = 95 * MiB;
constexpr size_t WS_QR = 112 * MiB;
constexpr size_t WS_KR = 121 * MiB;
constexpr size_t WS_VR = 130 * MiB;
constexpr size_t WS_GR = 147 * MiB;
constexpr size_t WS_MIX = 164 * MiB;
constexpr size_t WS_KV = 197 * MiB;
constexpr size_t WS_X1 = 214 * MiB;
constexpr size_t WS_H = 280 * MiB;
constexpr size_t WS_END = 411 * MiB;

constexpr int NWAVES = 8, NTHREADS = 512;
constexpr int LDS_BYTES = 147456;

__device__ const double INVF[40] = {
    1.0, 0.19392274474868576, 0.03760603093086393, 0.007292664737217109, 0.001414213562373095, 0.0002742481756762073, 5.318295896944988e-05, 1.031338537721246e-05,
    1.0, 0.7429639507594948, 0.551995432128157, 0.41011270705513014, 0.30469895709035083, 0.22638034095214482, 0.16819243248808696, 0.1249609141291987,
    0.09284145445194744, 0.06897785379387654, 0.05124805876960934, 0.038075460212223716, 0.028288694346259694, 0.021017480113324882, 0.015615230060004972,
    0.011601553017399714, 0.008619535664753033, 0.006404004271197283, 0.004757944314009409, 0.0035349811050301057, 0.0026263635276533325, 0.0019512934226359642,
    0.0014497406703726315, 0.001077105056036769, 0.0008002502278161052, 0.0005945570708544394, 0.00044173447031400687, 0.0003281927872511474,
    0.0002438354098268829, 0.00018116091942004152, 0.00013459603241553644, 0.0001};
__device__ __forceinline__ float log2g_of(int h) { return h == 0 ? -0.04580368961312479f : h == 1 ? -0.02272007650008353f : h == 2 ? -0.011315313227834146f : -0.005646563141142063f; }

__device__ __forceinline__ unsigned cvtpk(float lo, float hi) { f32x2 v = {lo, hi}; bf16x2_t b = __builtin_convertvector(v, bf16x2_t); return __builtin_bit_cast(unsigned, b); }
__device__ __forceinline__ float bf2f(unsigned short u) { return __uint_as_float((unsigned)u << 16); }
__device__ __forceinline__ float bflo(unsigned u) { return __uint_as_float(u << 16); }
__device__ __forceinline__ float bfhi(unsigned u) { return __uint_as_float(u & 0xffff0000u); }
__device__ __forceinline__ int row_bidx(int r) { return r < MP ? (r >> 11) : NB + ((r - MP) >> 3); }
__device__ __forceinline__ int row_tab(int r) { return r < MP ? (r & 2047) : 2048 + ((r - MP) & 7); }
__device__ __forceinline__ float wave_sum(float v) {
#pragma unroll
    for (int o = 1; o < 64; o <<= 1) v += __shfl_xor(v, o);
    return v;
}

namespace pg8 {
#define PG8_LAS __attribute__((address_space(3)))
constexpr int BM = 256, BK = 64, HALF = 128, HTB = HALF * BK * 2, STAGE_BYTES = 8 * HTB, NXCD = 8, WGM = 8;
__host__ __device__ __forceinline__ int lds_byte(int r, int c) { const int st = (r >> 4) * 2 + (c >> 5), rr = r & 15, cc = c & 31, ob = rr * 64 + cc * 2; return st * 1024 + (ob ^ (((ob >> 9) & 1) << 5)); }
__host__ __device__ __forceinline__ void stage_rc(int b, int& R, int& C) { const int st = b / 1024, sb = b % 1024, swz = sb ^ (((sb >> 9) & 1) << 5); R = (st >> 1) * 16 + swz / 64; C = (st & 1) * 32 + (swz % 64) / 2; }
__host__ __device__ __forceinline__ int perm32(int rho) { const int n = rho >> 4, i = rho & 15; return 8 * (i >> 2) + 4 * n + (i & 3); }
struct Unit { int pm, pn; };
struct Gemm { const bf16_t* A; const bf16_t* Bt; int M, N, K; };
struct StaticOrder {
    int nM, nN, nwg, G, c;
    __host__ __device__ void init(int M_, int N_, int G_, int c_) { nM = M_ / BM; nN = N_ / BM; nwg = nM * nN; G = G_; c = c_; }
    __host__ __device__ bool next(int i, Unit& u) const {
        const long L = (long)i * G + c; if (L >= nwg) return false;
        int wgid = (int)L; { const int q = nwg / NXCD, r = nwg % NXCD, xcd = wgid % NXCD, off = wgid / NXCD; wgid = (xcd < r ? xcd * (q + 1) : r * (q + 1) + (xcd - r) * q) + off; }
        const int nig = WGM * nN, gid = wgid / nig, fm = gid * WGM, gsz = (nM - fm) < WGM ? (nM - fm) : WGM;
        u.pm = fm + ((wgid % nig) % gsz); u.pn = (wgid % nig) / gsz; return true;
    }
    __device__ __forceinline__ void a_ready(const Unit&) const {}
    __device__ __forceinline__ void done(const Unit&) const {}
};

template <class Epi, class Sched, bool ALIGN_EPI = false, bool SP2 = false>
__device__ __forceinline__ void gemm_phase(PG8_LAS unsigned char* lds, const Gemm g, const Sched& S, const Epi& E) {
    const int tid = threadIdx.x, wid = __builtin_amdgcn_readfirstlane(tid >> 6), lane = tid & 63, wr = wid >> 2, wc = wid & 3, fr = lane & 15, fq = lane >> 4;
    const int K = g.K, nt = K / BK;
    unsigned voffA[2], voffB[2];
#pragma unroll
    for (int i = 0; i < 2; ++i) { int R, C; stage_rc(tid * 16 + i * 8192, R, C); const int Rb = Epi::PERM ? ((R & ~31) + perm32(R & 31)) : R;
        voffA[i] = (unsigned)(R * K + C) * 2u; voffB[i] = (unsigned)(Rb * K + C) * 2u; }
    const size_t kstep = (size_t)(BK * 2);
    const size_t hstep = (size_t)HALF * K * 2;
    const size_t tstep = 2 * hstep;
    const unsigned ldsw = (unsigned)wid * 1024u;
    const int aoff = lds_byte(wr * 64 + fr, fq * 8), boff = lds_byte(wc * 32 + fr, fq * 8);
#define PG8_SA(b, h) (((b) * 2 + (h)) * HTB)
#define PG8_SB(b, h) ((4 + (b) * 2 + (h)) * HTB)
#define PG8_STAGE(bufoff, gbase, voff) do { _Pragma("unroll") for (int _i = 0; _i < 2; ++_i) \
        __builtin_amdgcn_global_load_lds((const unsigned*)((const char*)(gbase) + (voff)[_i]), (PG8_LAS unsigned*)(lds + (bufoff) + ldsw + _i * 8192), 16, 0, 0); } while (0)
#define PG8_LDA(dst, b, h) do { _Pragma("unroll") for (int m = 0; m < 4; ++m) _Pragma("unroll") for (int k = 0; k < 2; ++k) dst[m][k] = *(const PG8_LAS bf16x8*)(lds + PG8_SA(b, h) + aoff + m * 2048 + k * 1024); } while (0)
#define PG8_LDB(dst, b, h) do { _Pragma("unroll") for (int n = 0; n < 2; ++n) _Pragma("unroll") for (int k = 0; k < 2; ++k) dst[n][k] = *(const PG8_LAS bf16x8*)(lds + PG8_SB(b, h) + boff + n * 2048 + k * 1024); } while (0)
#define PG8_MMA(ai, bj, At, Bt) do { __builtin_amdgcn_s_setprio(1); _Pragma("unroll") for (int m = 0; m < 4; ++m) _Pragma("unroll") for (int n = 0; n < 2; ++n) _Pragma("unroll") for (int k = 0; k < 2; ++k) \
        acc[ai][bj][m][n] = __builtin_amdgcn_mfma_f32_16x16x32_bf16(Bt[n][k], At[m][k], acc[ai][bj][m][n], 0, 0, 0); __builtin_amdgcn_s_setprio(0); } while (0)
#define PG8_WAIT_V(n) asm volatile("s_waitcnt vmcnt(" #n ")" ::: "memory")
#define PG8_WAIT_L(n) asm volatile("s_waitcnt lgkmcnt(" #n ")" ::: "memory")
#define PG8_BAR __builtin_amdgcn_s_barrier()
#define PG8_SCHED __builtin_amdgcn_sched_barrier(0)
    Unit cur, nxt; int ui = 0;
    if (!S.next(0, cur)) return;
    f32x4 acc[2][2][4][2];
#pragma unroll
    for (int a = 0; a < 2; ++a)
#pragma unroll
        for (int b = 0; b < 2; ++b)
#pragma unroll
            for (int m = 0; m < 4; ++m)
#pragma unroll
                for (int n = 0; n < 2; ++n) acc[a][b][m][n] = (f32x4){0.f, 0.f, 0.f, 0.f};
    bf16x8 At[4][2], B0[2][2], B1[2][2];
    const char* cA = (const char*)g.A + (size_t)cur.pm * tstep; const char* cB = (const char*)g.Bt + (size_t)cur.pn * tstep;
    S.a_ready(cur);
    if constexpr (SP2) {
        PG8_STAGE(PG8_SB(0, 0), cB, voffB); PG8_STAGE(PG8_SB(0, 1), cB + hstep, voffB); PG8_STAGE(PG8_SA(0, 0), cA, voffA); PG8_STAGE(PG8_SA(0, 1), cA + hstep, voffA);
        if (wr == 1) PG8_BAR;
        PG8_WAIT_V(2); PG8_BAR;
        PG8_STAGE(PG8_SB(1, 0), cB + kstep, voffB); PG8_STAGE(PG8_SA(1, 0), cA + kstep, voffA); PG8_STAGE(PG8_SB(1, 1), cB + hstep + kstep, voffB);
        PG8_WAIT_V(6); PG8_BAR;
    } else {
        PG8_STAGE(PG8_SB(0, 0), cB, voffB); PG8_STAGE(PG8_SA(0, 0), cA, voffA); PG8_STAGE(PG8_SB(0, 1), cB + hstep, voffB); PG8_STAGE(PG8_SA(0, 1), cA + hstep, voffA);
        if (wr == 1) PG8_BAR;
        PG8_WAIT_V(4); PG8_BAR;
        PG8_STAGE(PG8_SB(1, 0), cB + kstep, voffB); PG8_STAGE(PG8_SA(1, 0), cA + kstep, voffA); PG8_STAGE(PG8_SB(1, 1), cB + hstep + kstep, voffB);
        PG8_WAIT_V(6); PG8_BAR;
    }
    for (;;) {
        const bool has_next = S.next(ui + 1, nxt);
        const char* nA = has_next ? (const char*)g.A + (size_t)nxt.pm * tstep : cA; const char* nB = has_next ? (const char*)g.Bt + (size_t)nxt.pn * tstep : cB;
        for (int t = 0; t < nt; t += 2) {
            const bool last = (t == nt - 2);
            const char* a1 = cA + (size_t)(t + 1) * kstep;
            const char* a2 = last ? nA : cA + (size_t)(t + 2) * kstep; const char* b2 = last ? nB : cB + (size_t)(t + 2) * kstep;
            const char* a3 = a2 + kstep; const char* b3 = b2 + kstep;
            if (last && has_next) S.a_ready(nxt);
            if constexpr (SP2) {
            PG8_LDB(B0, 0, 0); PG8_LDB(B1, 0, 1); PG8_SCHED; PG8_LDA(At, 0, 0); PG8_STAGE(PG8_SA(1, 1), a1 + hstep, voffA);
            PG8_WAIT_V(8); PG8_WAIT_L(0); PG8_BAR; PG8_MMA(0, 0, At, B0); PG8_MMA(0, 1, At, B1); PG8_BAR; PG8_SCHED;
            PG8_LDA(At, 0, 1); PG8_STAGE(PG8_SB(0, 0), b2, voffB); PG8_STAGE(PG8_SB(0, 1), b2 + hstep, voffB); PG8_STAGE(PG8_SA(0, 0), a2, voffA);
            PG8_WAIT_V(8); PG8_WAIT_L(0); PG8_BAR; PG8_MMA(1, 0, At, B0); PG8_MMA(1, 1, At, B1); PG8_BAR; PG8_SCHED;
            PG8_LDB(B0, 1, 0); PG8_LDB(B1, 1, 1); PG8_SCHED; PG8_LDA(At, 1, 0); PG8_STAGE(PG8_SA(0, 1), a2 + hstep, voffA);
            PG8_WAIT_V(8); PG8_WAIT_L(0); PG8_BAR; PG8_MMA(0, 0, At, B0); PG8_MMA(0, 1, At, B1); PG8_BAR; PG8_SCHED;
            PG8_LDA(At, 1, 1); PG8_STAGE(PG8_SB(1, 0), b3, voffB); PG8_STAGE(PG8_SB(1, 1), b3 + hstep, voffB); PG8_STAGE(PG8_SA(1, 0), a3, voffA);
            PG8_WAIT_V(8); PG8_WAIT_L(0); PG8_BAR; PG8_MMA(1, 0, At, B0); PG8_MMA(1, 1, At, B1); PG8_BAR; PG8_SCHED;
            } else {
            PG8_LDB(B0, 0, 0); PG8_SCHED; PG8_LDA(At, 0, 0); PG8_STAGE(PG8_SA(1, 1), a1 + hstep, voffA);
            PG8_WAIT_L(8); PG8_BAR; PG8_WAIT_L(0); PG8_MMA(0, 0, At, B0); PG8_BAR; PG8_SCHED;
            PG8_LDB(B1, 0, 1); PG8_STAGE(PG8_SB(0, 0), b2, voffB);
            PG8_BAR; PG8_WAIT_L(0); PG8_MMA(0, 1, At, B1); PG8_BAR;
            PG8_LDA(At, 0, 1); PG8_STAGE(PG8_SA(0, 0), a2, voffA);
            PG8_BAR; PG8_WAIT_L(0); PG8_MMA(1, 0, At, B0); PG8_BAR; PG8_SCHED;
            PG8_STAGE(PG8_SB(0, 1), b2 + hstep, voffB);
            PG8_WAIT_V(6); PG8_BAR; PG8_MMA(1, 1, At, B1); PG8_BAR;
            PG8_LDB(B0, 1, 0); PG8_SCHED; PG8_LDA(At, 1, 0); PG8_STAGE(PG8_SA(0, 1), a2 + hstep, voffA);
            PG8_WAIT_L(8); PG8_BAR; PG8_WAIT_L(0); PG8_MMA(0, 0, At, B0); PG8_BAR; PG8_SCHED;
            PG8_LDB(B1, 1, 1); PG8_STAGE(PG8_SB(1, 0), b3, voffB);
            PG8_BAR; PG8_WAIT_L(0); PG8_MMA(0, 1, At, B1); PG8_BAR;
            PG8_LDA(At, 1, 1); PG8_STAGE(PG8_SA(1, 0), a3, voffA);
            PG8_BAR; PG8_WAIT_L(0); PG8_MMA(1, 0, At, B0); PG8_BAR; PG8_SCHED;
            PG8_STAGE(PG8_SB(1, 1), b3 + hstep, voffB);
            PG8_WAIT_V(6); PG8_BAR; PG8_MMA(1, 1, At, B1); PG8_BAR;
            }
        }
        if constexpr (ALIGN_EPI) { if (wr == 0) PG8_BAR; }
        E(acc, cur, wr, wc, fr, fq); S.done(cur);
        if (!has_next) break;
#pragma unroll
        for (int a = 0; a < 2; ++a)
#pragma unroll
            for (int b = 0; b < 2; ++b)
#pragma unroll
                for (int m = 0; m < 4; ++m)
#pragma unroll
                    for (int n = 0; n < 2; ++n) acc[a][b][m][n] = (f32x4){0.f, 0.f, 0.f, 0.f};
        cur = nxt; cA = nA; cB = nB; ++ui;
        if constexpr (ALIGN_EPI) { if (wr == 1) PG8_BAR; }
    }
    PG8_WAIT_V(0);
    if constexpr (!ALIGN_EPI) { if (wr == 0) PG8_BAR; }
    PG8_BAR;
#undef PG8_SA
#undef PG8_SB
#undef PG8_STAGE
#undef PG8_LDA
#undef PG8_LDB
#undef PG8_MMA
#undef PG8_WAIT_V
#undef PG8_WAIT_L
#undef PG8_BAR
#undef PG8_SCHED
}


struct EpiInProj {
    static constexpr bool PERM = false;
    bf16_t *QA, *KA, *VA, *QR, *KR, *VR, *GR; float* out; const f32x2* tabr; const f32x2* tabt;
    template <int TY> __device__ __forceinline__ void run(const f32x4 (&acc)[2][2][4][2], const Unit& u, int wr, int wc, int fr, int fq) const {
        const int cb = (TY <= 2 || TY >= 5) ? (u.pn & 1) * 256 : 0;
#pragma unroll
        for (int ai = 0; ai < 2; ++ai)
#pragma unroll
            for (int m = 0; m < 4; ++m) {
                const int r = u.pm * BM + ai * HALF + wr * 64 + m * 16 + fr;
                const int tp = row_tab(r);
#pragma unroll
                for (int bj = 0; bj < 2; ++bj)
#pragma unroll
                    for (int n = 0; n < 2; ++n) {
                        const int col = cb + bj * HALF + wc * 32 + n * 16 + fq * 4;
                        f32x4 v = acc[ai][bj][m][n];
                        if constexpr (TY == 0 || TY == 1) {
                            if (n == 0 && (wc & 1) == 0) {
                                const f32x2* tb = tabr + tp * 8 + (fq & 1) * 4;
#pragma unroll
                                for (int e = 0; e < 4; ++e) { const float pv = __shfl_xor(v[e], 32); const f32x2 cs = tb[e];
                                    v[e] = (fq < 2) ? (v[e] * cs.x - pv * cs.y) : (v[e] * cs.x + pv * cs.y); }
                            }
                            if constexpr (TY == 0) v = v * QSCALE;
                        }
                        if constexpr (TY == 3 || TY == 4) {
                            const f32x2* tb = tabt + tp * 32 + ((col & 63) >> 1);
                            const f32x2 c0 = tb[0], c1 = tb[1];
                            const float a0 = v[0] * c0.x - v[1] * c0.y, a1 = v[1] * c0.x + v[0] * c0.y, a2 = v[2] * c1.x - v[3] * c1.y, a3 = v[3] * c1.x + v[2] * c1.y;
                            v = (f32x4){a0, a1, a2, a3};
                            if constexpr (TY == 4) v = v * 0.125f;
                        }
                        if constexpr (TY == 6) {
#pragma unroll
                            for (int e = 0; e < 4; ++e) v[e] = v[e] / (1.0f + __builtin_amdgcn_exp2f(-1.4426950408889634f * v[e]));
                        }
                        if constexpr (TY == 1 || TY == 2) {
                            float* o = out + (TY == 1 ? (r < MP ? OFF_KP : OFF_KS) : (r < MP ? OFF_VP : OFF_VS)) + (size_t)(r < MP ? r : r - MP) * 512 + col;
                            *(f32x4*)o = v;
                        }
                        bf16_t* dst; int ld;
                        if constexpr (TY == 0) { dst = QA; ld = 512; } else if constexpr (TY == 1) { dst = KA; ld = 512; } else if constexpr (TY == 2) { dst = VA; ld = 512; }
                        else if constexpr (TY == 3) { dst = QR; ld = 256; } else if constexpr (TY == 4) { dst = KR; ld = 256; } else if constexpr (TY == 5) { dst = VR; ld = 512; } else { dst = GR; ld = 512; }
                        u32x2 w; w.x = cvtpk(v[0], v[1]); w.y = cvtpk(v[2], v[3]);
                        *(u32x2*)(dst + (size_t)r * ld + col) = w;
                    }
            }
    }
    __device__ __forceinline__ void operator()(const f32x4 (&acc)[2][2][4][2], const Unit& u, int wr, int wc, int fr, int fq) const {
        const int pn = u.pn;
        if (pn < 2) run<0>(acc, u, wr, wc, fr, fq);
        else if (pn < 4) run<1>(acc, u, wr, wc, fr, fq);
        else if (pn < 6) run<2>(acc, u, wr, wc, fr, fq);
        else if (pn == 6) run<3>(acc, u, wr, wc, fr, fq);
        else if (pn == 7) run<4>(acc, u, wr, wc, fr, fq);
        else if (pn < 10) run<5>(acc, u, wr, wc, fr, fq);
        else run<6>(acc, u, wr, wc, fr, fq);
    }
};
template <bool FROM_X> struct EpiResid {
    static constexpr bool PERM = false;
    const float* xp; const float* xs; float* dst; const float* gate; int gld;
    __device__ __forceinline__ void operator()(const f32x4 (&acc)[2][2][4][2], const Unit& u, int wr, int wc, int fr, int fq) const {
#pragma unroll
        for (int ai = 0; ai < 2; ++ai)
#pragma unroll
            for (int m = 0; m < 4; ++m) {
                const int r = u.pm * BM + ai * HALF + wr * 64 + m * 16 + fr;
                const float* g = gate + (size_t)row_bidx(r) * gld;
                const float* base = FROM_X ? (r < MP ? xp + (size_t)r * D : xs + (size_t)(r - MP) * D) : dst + (size_t)r * D;
#pragma unroll
                for (int bj = 0; bj < 2; ++bj)
#pragma unroll
                    for (int n = 0; n < 2; ++n) {
                        const int col = u.pn * BM + bj * HALF + wc * 32 + n * 16 + fq * 4;
                        const f32x4 b = *(const f32x4*)(base + col), gg = *(const f32x4*)(g + col);
                        *(f32x4*)(dst + (size_t)r * D + col) = b + gg * acc[ai][bj][m][n];
                    }
            }
    }
};
struct EpiRelu2 {
    static constexpr bool PERM = true;
    bf16_t* O; int ldc;
    __device__ __forceinline__ void operator()(const f32x4 (&acc)[2][2][4][2], const Unit& u, int wr, int wc, int fr, int fq) const {
        const int row0 = u.pm * BM + wr * 64 + fr, col0 = u.pn * BM + wc * 32 + 8 * fq;
#pragma unroll
        for (int ai = 0; ai < 2; ++ai)
#pragma unroll
            for (int m = 0; m < 4; ++m) { bf16_t* rowp = O + (size_t)(row0 + ai * HALF + m * 16) * ldc + col0;
#pragma unroll
                for (int bj = 0; bj < 2; ++bj) { f32x4 v0 = acc[ai][bj][m][0], v1 = acc[ai][bj][m][1];
#pragma unroll
                    for (int e = 0; e < 4; ++e) { const float a = fmaxf(v0[e], 0.f), b = fmaxf(v1[e], 0.f); v0[e] = a * a; v1[e] = b * b; }
                    u32x4 w; w.x = cvtpk(v0[0], v0[1]); w.y = cvtpk(v0[2], v0[3]); w.z = cvtpk(v1[0], v1[1]); w.w = cvtpk(v1[2], v1[3]);
                    *(u32x4*)(rowp + bj * HALF) = w; } }
    }
};
}

struct Args { const float* in[16]; float* out; unsigned char* ws; int ph_lo, ph_hi; };
struct Frame {
    LAS unsigned char* lds;
    int tid, lane, wave, vcu, G;
    const Args* a;
#define FIN(i) ((const float*)F.a->in[i])
#define FWS(T, off) ((T*)(F.a->ws + (off)))
};
#define F_xp FIN(0)
#define F_xs FIN(1)
#define F_cp FIN(2)
#define F_cs FIN(3)
#define F_ck FIN(4)
#define F_cv FIN(5)
#define F_st FIN(6)
#define F_w_ada FIN(7)
#define F_b_ada FIN(8)
#define F_w_in FIN(9)
#define F_gain FIN(10)
#define F_w_out FIN(11)
#define F_w_ff1 FIN(12)
#define F_w_ff2 FIN(13)
#define F_w_adaf FIN(14)
#define F_b_adaf FIN(15)
#define F_out (F.a->out)
#define F_MOD FWS(float, WS_MOD)
#define F_MODF FWS(float, WS_MODF)
#define F_TABR FWS(f32x2, WS_TABR)
#define F_TABT FWS(f32x2, WS_TABT)
#define F_WIN FWS(bf16_t, WS_WIN)
#define F_WOUT FWS(bf16_t, WS_WOUT)
#define F_W1 FWS(bf16_t, WS_W1)
#define F_W2 FWS(bf16_t, WS_W2)
#define F_XN FWS(bf16_t, WS_XN)
#define F_QA FWS(bf16_t, WS_QA)
#define F_KA FWS(bf16_t, WS_KA)
#define F_VA FWS(bf16_t, WS_VA)
#define F_QR FWS(bf16_t, WS_QR)
#define F_KR FWS(bf16_t, WS_KR)
#define F_VR FWS(bf16_t, WS_VR)
#define F_GR FWS(bf16_t, WS_GR)
#define F_MIX FWS(bf16_t, WS_MIX)
#define F_H FWS(bf16_t, WS_H)
#define F_KV FWS(float, WS_KV)
#define F_X1 FWS(float, WS_X1)

__device__ __forceinline__ unsigned f2bf(float f) { unsigned u = __builtin_bit_cast(unsigned, f); return (u + 0x7fffu + ((u >> 16) & 1u)) >> 16; }
__device__ __forceinline__ unsigned pk2(float lo, float hi) { return f2bf(lo) | (f2bf(hi) << 16); }
__device__ __forceinline__ void p0_transpose_item(const float* W, int K, int N, bf16_t* WT, LAS float* scr, int item, int lane) {
    const int nblk = N / 32, kb = item / nblk, nb = item % nblk, k0 = 64 * kb, n0 = 32 * nb;
#pragma unroll 8
    for (int i = 0; i < 32; ++i) { const int kk = 2 * i + (lane >> 5); scr[kk * 33 + (lane & 31)] = W[(size_t)(k0 + kk) * N + n0 + (lane & 31)]; }
    asm volatile("s_waitcnt lgkmcnt(0)" ::: "memory");
    const int c = lane & 7;
#pragma unroll
    for (int j = 0; j < 4; ++j) { const int n = (lane >> 3) + 8 * j; const LAS float* s = scr + (8 * c) * 33 + n;
        u32x4 o; o.x = pk2(s[0 * 33], s[1 * 33]); o.y = pk2(s[2 * 33], s[3 * 33]); o.z = pk2(s[4 * 33], s[5 * 33]); o.w = pk2(s[6 * 33], s[7 * 33]);
        *(u32x4*)(WT + (size_t)(n0 + n) * K + k0 + 8 * c) = o; }
    asm volatile("s_waitcnt lgkmcnt(0)" ::: "memory");
}
__device__ __forceinline__ void sincos_d(double x, float& sn, float& cs) {
    const double k = __builtin_rint(x * 0.63661977236758134308);
    double r = __builtin_fma(-k, 1.57079632679489655800e+00, x); r = __builtin_fma(-k, 6.12323399573676603587e-17, r);
    const double r2 = r * r;
    double s = -7.6471637318198164759e-13; s = s * r2 + 1.6059043836821614599e-10; s = s * r2 - 2.5052108385441718775e-08; s = s * r2 + 2.7557319223985890653e-06;
    s = s * r2 - 1.9841269841269841270e-04; s = s * r2 + 8.3333333333333333333e-03; s = s * r2 - 1.6666666666666666667e-01; s = r + r * r2 * s;
    double c = 4.7794773323873852974e-14; c = c * r2 - 1.1470745597729724714e-11; c = c * r2 + 2.0876756987868098979e-09; c = c * r2 - 2.7557319223985890653e-07;
    c = c * r2 + 2.4801587301587301587e-05; c = c * r2 - 1.3888888888888888889e-03; c = c * r2 + 4.1666666666666666667e-02; c = c * r2 - 0.5; c = 1.0 + r2 * c;
    const int q = ((int)k) & 3;
    const double ss = (q == 0) ? s : (q == 1) ? c : (q == 2) ? -s : -c;
    const double cc = (q == 0) ? c : (q == 1) ? -s : (q == 2) ? -c : s;
    sn = (float)ss; cs = (float)cc;
}
__device__ __forceinline__ void p0_prologue(Frame& F) {
    {
        const int w = F.wave, lane = F.lane, hh = lane >> 5, cl = lane & 31;
        LAS float* sst = (LAS float*)(F.lds + w * 16384);
        for (int item = F.vcu; item < 256; item += F.G) {
            const bool fin = item >= 192; const int col = (fin ? item - 192 : item) * 32 + cl;
            const float* W = fin ? F_w_adaf : F_w_ada; const int ldw = fin ? 2048 : 6144;
            float acc[NMODB];
#pragma unroll
            for (int r = 0; r < NMODB; ++r) acc[r] = 0.f;
            for (int sub = 0; sub < 4; ++sub) {
                const int kb = 128 * w + 16 * sub;
#pragma unroll 4
                for (int i = 0; i < 20; ++i) { const int idx = lane + 64 * i, h2 = idx / 640, rem = idx % 640, r = rem >> 4, kk = rem & 15, k = kb + 64 * h2 + kk;
                    const float c = r < NB ? F_cp[r * D + k] : F_cs[(r - NB) * D + k];
                    sst[idx] = c / (1.0f + __expf(-c)); }
                asm volatile("s_waitcnt lgkmcnt(0)" ::: "memory");
#pragma unroll 1
                for (int k4 = 0; k4 < 4; ++k4) {
                    const int k = kb + 64 * hh + 4 * k4;
                    const float w0 = W[(size_t)(k + 0) * ldw + col], w1 = W[(size_t)(k + 1) * ldw + col], w2 = W[(size_t)(k + 2) * ldw + col], w3 = W[(size_t)(k + 3) * ldw + col];
#pragma unroll
                    for (int r = 0; r < NMODB; ++r) { const f32x4 s4 = *(const LAS f32x4*)(sst + hh * 640 + r * 16 + 4 * k4);
                        acc[r] += s4.x * w0 + s4.y * w1 + s4.z * w2 + s4.w * w3;
                        if ((r & 7) == 7) __builtin_amdgcn_sched_barrier(0); }
                }
                asm volatile("s_waitcnt lgkmcnt(0)" ::: "memory");
            }
            __syncthreads();
            LAS float* red = (LAS float*)F.lds;
#pragma unroll
            for (int r = 0; r < NMODB; ++r) red[((2 * w + hh) * NMODB + r) * 32 + cl] = acc[r];
            __syncthreads();
            for (int o = F.tid; o < NMODB * 32; o += NTHREADS) { const int r = o >> 5, c2 = o & 31; float s = 0.f;
#pragma unroll
                for (int p = 0; p < 16; ++p) s += red[(p * NMODB + r) * 32 + c2];
                const int oc = (fin ? item - 192 : item) * 32 + c2;
                if (fin) F_MODF[r * 2048 + oc] = s + F_b_adaf[oc]; else F_MOD[r * 6144 + oc] = s + F_b_ada[oc]; }
            __syncthreads();
        }
    }
    {
        LAS float* scr = (LAS float*)(F.lds + F.wave * 16384);
        const int gw = F.vcu * NWAVES + F.wave, NGW = F.G * NWAVES;
        constexpr int I_IN = (D / 64) * (NIN / 32), I_O = (D / 64) * (D / 32), I_1 = (D / 64) * (FF / 32), I_2 = (FF / 64) * (D / 32);
        constexpr int NITEMS = I_IN + I_O + I_1 + I_2;
        for (int it = gw; it < NITEMS; it += NGW) {
            int r = it;
            if (r < I_IN) { p0_transpose_item(F_w_in, D, NIN, F_WIN, scr, r, F.lane); continue; } r -= I_IN;
            if (r < I_O) { p0_transpose_item(F_w_out, D, D, F_WOUT, scr, r, F.lane); continue; } r -= I_O;
            if (r < I_1) { p0_transpose_item(F_w_ff1, D, FF, F_W1, scr, r, F.lane); continue; } r -= I_1;
            p0_transpose_item(F_w_ff2, FF, D, F_W2, scr, r, F.lane);
        }
    }
    {
        const int gt = F.vcu * NTHREADS + F.tid, NT = F.G * NTHREADS;
        for (int i = gt; i < 2056 * 40; i += NT) { const int p = i / 40, j = i % 40; const int pos = p < 2048 ? p : 8192 + (p - 2048);
            float sn, cs; sincos_d((double)pos * INVF[j], sn, cs);
            if (j < 8) F_TABR[p * 8 + j] = (f32x2){cs, sn}; else F_TABT[p * 32 + (j - 8)] = (f32x2){cs, sn}; }
    }
}

template <int MODE> __device__ __forceinline__ void norm_rows(Frame& F) {
    const int gw = F.vcu * NWAVES + F.wave, NGW = F.G * NWAVES;
    for (int m = gw; m < M; m += NGW) {
        const float* xrow = MODE == 0 ? (m < MP ? F_xp + (size_t)m * D : F_xs + (size_t)(m - MP) * D) : F_X1 + (size_t)m * D;
        const f32x4* xr = (const f32x4*)xrow + F.lane;
        f32x4 v[4]; float s = 0.f;
#pragma unroll
        for (int j = 0; j < 4; ++j) { v[j] = xr[64 * j]; s += (v[j].x * v[j].x + v[j].y * v[j].y) + (v[j].z * v[j].z + v[j].w * v[j].w); }
        const float rstd = 1.0f / sqrtf(wave_sum(s) * (1.f / D) + EPS);
        const int bi = row_bidx(m);
        const float* shp = MODE == 0 ? F_MOD + (size_t)bi * 6144 : MODE == 1 ? F_MOD + (size_t)bi * 6144 + 3072 : F_MODF + (size_t)bi * 2048;
        const float* scp = shp + 1024;
#pragma unroll
        for (int j = 0; j < 4; ++j) {
            const f32x4 sh = ((const f32x4*)shp)[F.lane + 64 * j], sc = ((const f32x4*)scp)[F.lane + 64 * j];
            const f32x4 o = v[j] * rstd * (sc + 1.0f) + sh;
            if constexpr (MODE == 2) ((f32x4*)(F_out + OFF_Y + (size_t)m * D))[F.lane + 64 * j] = o;
            else { u32x2 w; w.x = cvtpk(o.x, o.y); w.y = cvtpk(o.z, o.w); ((u32x2*)(F_XN + (size_t)m * D))[F.lane + 64 * j] = w; }
        }
    }
}

typedef short v4i16_t __attribute__((ext_vector_type(4)));
template <bool PERMK> __device__ __forceinline__ bf16x8 trfrag(LAS const unsigned char* img, int k0, int lane) {
    const int hi = lane >> 5, gb = (lane >> 4) & 1, q = (lane >> 2) & 3, p = lane & 3;
    const int ra = PERMK ? (k0 + 4 * hi + q) : (k0 + 8 * hi + q), rb = PERMK ? (ra + 8) : (ra + 4);
    LAS const unsigned char* pa = img + ra * 64 + (16 * gb + 4 * p) * 2; LAS const unsigned char* pb = img + rb * 64 + (16 * gb + 4 * p) * 2;
    const s16x4 lo = __builtin_bit_cast(s16x4, __builtin_amdgcn_ds_read_tr16_b64_v4i16((LAS v4i16_t*)pa));
    const s16x4 h4 = __builtin_bit_cast(s16x4, __builtin_amdgcn_ds_read_tr16_b64_v4i16((LAS v4i16_t*)pb));
    return (bf16x8){lo[0], lo[1], lo[2], lo[3], h4[0], h4[1], h4[2], h4[3]};
}
__device__ __forceinline__ bf16x8 pack8(float a0, float a1, float a2, float a3, float a4, float a5, float a6, float a7) {
    u32x4 w; w.x = cvtpk(a0, a1); w.y = cvtpk(a2, a3); w.z = cvtpk(a4, a5); w.w = cvtpk(a6, a7); return __builtin_bit_cast(bf16x8, w);
}
__device__ __forceinline__ bf16x8 ld8_bf16(const bf16_t* p) { return *(const bf16x8*)p; }
__device__ __forceinline__ bf16x8 ld8_f32(const float* p) { const f32x4 a = *(const f32x4*)p, b = *(const f32x4*)(p + 4); return pack8(a.x, a.y, a.z, a.w, b.x, b.y, b.z, b.w); }

struct AttnAcc { f32x16 o0, o1; float m, l; };
template <int BR, bool EXCL, bool QMASK>
__device__ __forceinline__ void attn_step(AttnAcc& A, const bf16x8 (&kf)[4], const bf16x8 (&qf)[4], LAS const unsigned char* vimg, int qp, bool qvalid, int p0, int s_hi, int s_lo, int lane) {
    const int hi = lane >> 5;
    f32x16 s = {0.f, 0.f, 0.f, 0.f, 0.f, 0.f, 0.f, 0.f, 0.f, 0.f, 0.f, 0.f, 0.f, 0.f, 0.f, 0.f};
#pragma unroll
    for (int d0 = 0; d0 < 4; ++d0) s = __builtin_amdgcn_mfma_f32_32x32x16_bf16(kf[d0], qf[d0], s, 0, 0, 0);
    const int pbase = p0 + 4 * hi * s_lo, dbase = qp - pbase;
    float mu[16]; float tmax = -1e30f;
#pragma unroll
    for (int r = 0; r < 16; ++r) {
        const int off = (r >> 2) * s_hi + (r & 3) * s_lo, dist = dbase - off, pos = pbase + off;
        int ml = 0;
        if (BR & 1) ml += (dist <= 128) ? 1 : 0;
        if (BR & 2) ml += ((dist & 3) == 0 && dist <= 512) ? 1 : 0;
        if (BR & 4) ml += ((dist & 15) == 0 && dist <= 2048) ? 1 : 0;
        if (EXCL && (dist & 15) == 0) ml = 0;
        if (dist < 0 || pos < 0) ml = 0;
        if (QMASK && !qvalid) ml = 0;
        mu[r] = (float)ml;
        s[r] = ml ? s[r] : -1e30f; tmax = fmaxf(tmax, s[r]);
    }
    tmax = fmaxf(tmax, __shfl_xor(tmax, 32));
    const float mn = fmaxf(A.m, tmax), alpha = __builtin_amdgcn_exp2f(A.m - mn); A.m = mn;
    float ps = 0.f;
#pragma unroll
    for (int r = 0; r < 16; ++r) { s[r] = mu[r] * __builtin_amdgcn_exp2f(s[r] - mn); ps += s[r]; }
    A.l = A.l * alpha + ps;
    A.o0 = A.o0 * alpha; A.o1 = A.o1 * alpha;
    const bf16x8 pf0 = pack8(s[0], s[1], s[2], s[3], s[4], s[5], s[6], s[7]), pf1 = pack8(s[8], s[9], s[10], s[11], s[12], s[13], s[14], s[15]);
    A.o0 = __builtin_amdgcn_mfma_f32_32x32x16_bf16(trfrag<true>(vimg, 0, lane), pf0, A.o0, 0, 0, 0);
    A.o0 = __builtin_amdgcn_mfma_f32_32x32x16_bf16(trfrag<true>(vimg, 16, lane), pf1, A.o0, 0, 0, 0);
    A.o1 = __builtin_amdgcn_mfma_f32_32x32x16_bf16(trfrag<true>(vimg + 2048, 0, lane), pf0, A.o1, 0, 0, 0);
    A.o1 = __builtin_amdgcn_mfma_f32_32x32x16_bf16(trfrag<true>(vimg + 2048, 16, lane), pf1, A.o1, 0, 0, 0);
}
template <bool F32SRC> struct TileRegs { bf16x8 kf[4]; bf16x8 vs[4]; };
template <bool F32SRC> __device__ __forceinline__ void tile_load(TileRegs<F32SRC>& T, const void* kb, const void* vb, long rowbase, int pmax, int p0, int s_hi, int s_lo, int lane) {
    const int r32 = lane & 31, hi = lane >> 5;
    int pk = p0 + (r32 >> 3) * s_hi + (r32 & 7) * s_lo; pk = pk < 0 ? 0 : (pk > pmax ? pmax : pk);
    const int kv = lane >> 1; int pv = p0 + (kv >> 3) * s_hi + (kv & 7) * s_lo; pv = pv < 0 ? 0 : (pv > pmax ? pmax : pv);
    if constexpr (F32SRC) {
        const float* kr = (const float*)kb + (rowbase + pk) * 512 + 8 * hi; const float* vr = (const float*)vb + (rowbase + pv) * 512 + 32 * (lane & 1);
#pragma unroll
        for (int d0 = 0; d0 < 4; ++d0) T.kf[d0] = ld8_f32(kr + 16 * d0);
#pragma unroll
        for (int j = 0; j < 4; ++j) T.vs[j] = ld8_f32(vr + 8 * j);
    } else {
        const bf16_t* kr = (const bf16_t*)kb + (rowbase + pk) * 512 + 8 * hi; const bf16_t* vr = (const bf16_t*)vb + (rowbase + pv) * 512 + 32 * (lane & 1);
#pragma unroll
        for (int d0 = 0; d0 < 4; ++d0) T.kf[d0] = ld8_bf16(kr + 16 * d0);
#pragma unroll
        for (int j = 0; j < 4; ++j) T.vs[j] = ld8_bf16(vr + 8 * j);
    }
}
template <bool F32SRC> __device__ __forceinline__ void tile_stage_v(const TileRegs<F32SRC>& T, LAS unsigned char* vimg, int lane) {
    LAS unsigned char* d = vimg + (lane & 1) * 2048 + (lane >> 1) * 64;
#pragma unroll
    for (int j = 0; j < 4; ++j) *(LAS bf16x8*)(d + 16 * j) = T.vs[j];
}
__device__ __forceinline__ void attn_store(const AttnAcc& A, bf16_t* mixrow, int lane) {
    const int hi = lane >> 5;
    const float lt = A.l + __shfl_xor(A.l, 32), inv = 1.0f / lt;
#pragma unroll
    for (int g = 0; g < 4; ++g) {
        u32x2 w0, w1; w0.x = cvtpk(A.o0[4 * g] * inv, A.o0[4 * g + 1] * inv); w0.y = cvtpk(A.o0[4 * g + 2] * inv, A.o0[4 * g + 3] * inv);
        w1.x = cvtpk(A.o1[4 * g] * inv, A.o1[4 * g + 1] * inv); w1.y = cvtpk(A.o1[4 * g + 2] * inv, A.o1[4 * g + 3] * inv);
        *(u32x2*)(mixrow + 8 * g + 4 * hi) = w0; *(u32x2*)(mixrow + 32 + 8 * g + 4 * hi) = w1;
    }
}
#define WAVE_LDS_FENCE() asm volatile("s_waitcnt lgkmcnt(0)" ::: "memory")

__device__ __forceinline__ void prompt_attn_tile(Frame& F, int b, int h, int rho, int c, LAS unsigned char* vimg) {
    const int lane = F.lane, r32 = lane & 31, hi = lane >> 5;
    const int T0 = 512 * c + rho, qp = T0 + 16 * r32;
    const long rowbase = (long)b * SEQ;
    const bf16_t* Qp = F_QA + h * 64; const bf16_t* Kp = F_KA + h * 64; const bf16_t* Vp = F_VA + h * 64;
    bf16x8 qf[4];
#pragma unroll
    for (int d0 = 0; d0 < 4; ++d0) qf[d0] = ld8_bf16(Qp + (rowbase + qp) * 512 + 16 * d0 + 8 * hi);
    AttnAcc A; A.m = -1e30f; A.l = 0.f;
#pragma unroll
    for (int r = 0; r < 16; ++r) { A.o0[r] = 0.f; A.o1[r] = 0.f; }
    TileRegs<false> T;
    for (int ti = 0; ti < 5; ++ti) { const int p0 = T0 - 2048 + 512 * ti; if (p0 + 496 < 0) continue;
        tile_load<false>(T, Kp, Vp, rowbase, SEQ - 1, p0, 128, 16, lane); tile_stage_v<false>(T, vimg, lane); WAVE_LDS_FENCE();
        attn_step<7, false, false>(A, T.kf, qf, vimg, qp, true, p0, 128, 16, lane); WAVE_LDS_FENCE(); }
    for (int ti = 0; ti < 3; ++ti) { const int p0 = T0 - 512 + 128 * ti; if (p0 + 124 < 0) continue;
        tile_load<false>(T, Kp, Vp, rowbase, SEQ - 1, p0, 32, 4, lane); tile_stage_v<false>(T, vimg, lane); WAVE_LDS_FENCE();
        attn_step<7, true, false>(A, T.kf, qf, vimg, qp, true, p0, 32, 4, lane); WAVE_LDS_FENCE(); }
    for (int ti = 0; ti < 20; ++ti) { const int p0 = T0 - 128 + 32 * ti; if (p0 + 31 < 0 || p0 > SEQ - 1) continue;
        tile_load<false>(T, Kp, Vp, rowbase, SEQ - 1, p0, 8, 1, lane); tile_stage_v<false>(T, vimg, lane); WAVE_LDS_FENCE();
        attn_step<7, true, false>(A, T.kf, qf, vimg, qp, true, p0, 8, 1, lane); WAVE_LDS_FENCE(); }
    attn_store(A, F_MIX + (rowbase + qp) * D + h * 64, lane);
}

__device__ __forceinline__ void sample_attn_item(Frame& F, int sb, int h) {
    const int lane = F.lane, r32 = lane & 31, hi = lane >> 5, w = F.wave;
    LAS unsigned char* vimg = F.lds + w * 4096;
    const bool qvalid = r32 < DT; const int qp = LCACHE + (qvalid ? r32 : 0);
    bf16x8 qf[4];
#pragma unroll
    for (int d0 = 0; d0 < 4; ++d0) qf[d0] = ld8_bf16(F_QA + (size_t)(MP + sb * DT + (qvalid ? r32 : 0)) * 512 + h * 64 + 16 * d0 + 8 * hi);
    AttnAcc A; A.m = -1e30f; A.l = 0.f;
#pragma unroll
    for (int r = 0; r < 16; ++r) { A.o0[r] = 0.f; A.o1[r] = 0.f; }
    for (int ti = w; ti < 41; ti += NWAVES) {
        if (ti == 0) {
            TileRegs<false> T; tile_load<false>(T, F_KA + h * 64, F_VA + h * 64, (long)(MP + sb * DT) - LCACHE, LCACHE + DT - 1, LCACHE, 8, 1, lane);
            tile_stage_v<false>(T, vimg, lane); WAVE_LDS_FENCE();
            attn_step<7, false, true>(A, T.kf, qf, vimg, qp, qvalid, LCACHE, 8, 1, lane); WAVE_LDS_FENCE();
        } else {
            const int p0 = ti <= 16 ? (LCACHE - 512 + 32 * (ti - 1)) : 64 * (ti - 17); const int s_hi = ti <= 16 ? 8 : 16;
            TileRegs<true> T; tile_load<true>(T, F_ck + h * 64, F_cv + h * 64, (long)sb * LCACHE, LCACHE - 1, p0, s_hi, 1, lane);
            tile_stage_v<true>(T, vimg, lane); WAVE_LDS_FENCE();
            attn_step<7, false, true>(A, T.kf, qf, vimg, qp, qvalid, p0, s_hi, 1, lane); WAVE_LDS_FENCE();
        }
    }
    LAS float* po = (LAS float*)(F.lds + 32768); LAS float* pm = po + 8 * 8 * 64; LAS float* pl = pm + 64;
    const float lt = A.l + __shfl_xor(A.l, 32);
    if (qvalid) {
#pragma unroll
        for (int g = 0; g < 4; ++g) {
            *(LAS f32x4*)(po + (w * 8 + r32) * 64 + 8 * g + 4 * hi) = (f32x4){A.o0[4 * g], A.o0[4 * g + 1], A.o0[4 * g + 2], A.o0[4 * g + 3]};
            *(LAS f32x4*)(po + (w * 8 + r32) * 64 + 32 + 8 * g + 4 * hi) = (f32x4){A.o1[4 * g], A.o1[4 * g + 1], A.o1[4 * g + 2], A.o1[4 * g + 3]};
        }
        if (hi == 0) { pm[w * 8 + r32] = A.m; pl[w * 8 + r32] = lt; }
    }
    __syncthreads();
    {
        const int q = F.tid >> 6, d = F.tid & 63;
        float mm = -1e30f;
#pragma unroll
        for (int ww = 0; ww < 8; ++ww) mm = fmaxf(mm, pm[ww * 8 + q]);
        float L = 0.f, O = 0.f;
#pragma unroll
        for (int ww = 0; ww < 8; ++ww) { const float f = __builtin_amdgcn_exp2f(pm[ww * 8 + q] - mm); L += pl[ww * 8 + q] * f; O += po[(ww * 8 + q) * 64 + d] * f; }
        const float o = O / L;
        F_MIX[(size_t)(MP + sb * DT + q) * D + h * 64 + d] = (bf16_t)f2bf(o);
    }
    __syncthreads();
}

__device__ __forceinline__ void ret_kv_item(Frame& F, int b, int h, int j) {
    const int tid = F.tid, lane = F.lane, w = F.wave;
    LAS unsigned char* kimg = F.lds;
    LAS unsigned char* vimg = F.lds + 16384;
    const size_t R0 = (size_t)b * SEQ + (size_t)j * 128;
    const float lg = log2g_of(h);
#pragma unroll
    for (int i = 0; i < 2; ++i) { const int id = tid + NTHREADS * i, row = id >> 3, ch = id & 7;
        const bf16x8 v = *(const bf16x8*)(F_KR + (R0 + row) * 256 + h * 64 + 8 * ch);
        *(LAS bf16x8*)(kimg + (ch >> 2) * 8192 + row * 64 + (ch & 3) * 16) = v; }
#pragma unroll
    for (int i = 0; i < 4; ++i) { const int id = tid + NTHREADS * i, row = id >> 4, ch = id & 15;
        const u32x4 v = *(const u32x4*)(F_VR + (R0 + row) * 512 + h * 128 + 8 * ch);
        const float sc = __builtin_amdgcn_exp2f((float)(127 - row) * lg);
        u32x4 o; o.x = cvtpk(bflo(v.x) * sc, bfhi(v.x) * sc); o.y = cvtpk(bflo(v.y) * sc, bfhi(v.y) * sc); o.z = cvtpk(bflo(v.z) * sc, bfhi(v.z) * sc); o.w = cvtpk(bflo(v.w) * sc, bfhi(v.w) * sc);
        *(LAS u32x4*)(vimg + (ch >> 2) * 8192 + row * 64 + (ch & 3) * 16) = o; }
    __syncthreads();
    const int db = w >> 2, eb = w & 3;
    f32x16 acc;
#pragma unroll
    for (int r = 0; r < 16; ++r) acc[r] = 0.f;
#pragma unroll
    for (int s = 0; s < 8; ++s)
        acc = __builtin_amdgcn_mfma_f32_32x32x16_bf16(trfrag<false>(kimg + db * 8192, 16 * s, lane), trfrag<false>(vimg + eb * 8192, 16 * s, lane), acc, 0, 0, 0);
    float* kvo = F_KV + ((size_t)((b * 4 + h) * 16 + j)) * 8192;
    const int r32 = lane & 31, hi = lane >> 5;
#pragma unroll
    for (int r = 0; r < 16; ++r) { const int d = 32 * db + (r & 3) + 8 * (r >> 2) + 4 * hi; kvo[d * 128 + 32 * eb + r32] = acc[r]; }
    __syncthreads();
}
__device__ __forceinline__ void ret_out_item(Frame& F, int b, int h, int c) {
    const int tid = F.tid, lane = F.lane, w = F.wave, r32 = lane & 31, hi = lane >> 5;
    LAS unsigned char* vimg = F.lds;
    LAS unsigned char* simg = F.lds + 32768;
    LAS float* stat = (LAS float*)(F.lds + 49152);
    const size_t R0 = (size_t)b * SEQ + (size_t)c * 128;
    const float lg = log2g_of(h), gam = __builtin_amdgcn_exp2f(128.f * lg);
#pragma unroll
    for (int i = 0; i < 4; ++i) { const int id = tid + NTHREADS * i, row = id >> 4, ch = id & 15;
        const bf16x8 v = *(const bf16x8*)(F_VR + (R0 + row) * 512 + h * 128 + 8 * ch);
        *(LAS bf16x8*)(vimg + (ch >> 2) * 8192 + row * 64 + (ch & 3) * 16) = v; }
    {
        const float* kvb = F_KV + (size_t)((b * 4 + h) * 16) * 8192;
        f32x4 S[4];
#pragma unroll
        for (int i = 0; i < 4; ++i) S[i] = (f32x4){0.f, 0.f, 0.f, 0.f};
        for (int j = 0; j < c; ++j) {
#pragma unroll
            for (int i = 0; i < 4; ++i) S[i] = S[i] * gam + *(const f32x4*)(kvb + (size_t)j * 8192 + 4 * (tid + NTHREADS * i));
        }
#pragma unroll
        for (int i = 0; i < 4; ++i) { const int gi = tid + NTHREADS * i, d = gi >> 5, e0 = (gi & 31) * 4;
            u32x2 o; o.x = cvtpk(S[i].x, S[i].y); o.y = cvtpk(S[i].z, S[i].w);
            *(LAS u32x2*)(simg + (e0 >> 5) * 4096 + d * 64 + (e0 & 31) * 2) = o; }
        if (c == 15) {
            float* rp = F_out + OFF_RP + (size_t)(b * 4 + h) * 8192;
#pragma unroll
            for (int i = 0; i < 4; ++i) { const f32x4 fin = S[i] * gam + *(const f32x4*)(kvb + (size_t)15 * 8192 + 4 * (tid + NTHREADS * i)); *(f32x4*)(rp + 4 * (tid + NTHREADS * i)) = fin; }
        }
    }
    __syncthreads();
    const int wq = w >> 1, we = w & 1;
    const int q = 32 * wq + r32;
    bf16x8 qf[4];
#pragma unroll
    for (int s = 0; s < 4; ++s) qf[s] = ld8_bf16(F_QR + (R0 + q) * 256 + h * 64 + 16 * s + 8 * hi);
    f32x16 o[2];
#pragma unroll
    for (int r = 0; r < 16; ++r) { o[0][r] = 0.f; o[1][r] = 0.f; }
#pragma unroll
    for (int eb = 0; eb < 2; ++eb)
#pragma unroll
        for (int s = 0; s < 4; ++s) o[eb] = __builtin_amdgcn_mfma_f32_32x32x16_bf16(trfrag<false>(simg + (2 * we + eb) * 4096, 16 * s, lane), qf[s], o[eb], 0, 0, 0);
    { const float gq = __builtin_amdgcn_exp2f((float)(q + 1) * lg); o[0] = o[0] * gq; o[1] = o[1] * gq; }
    for (int jb = 0; jb <= wq; ++jb) {
        bf16x8 kf[4];
#pragma unroll
        for (int s = 0; s < 4; ++s) kf[s] = ld8_bf16(F_KR + (R0 + 32 * jb + r32) * 256 + h * 64 + 16 * s + 8 * hi);
        f32x16 st;
#pragma unroll
        for (int r = 0; r < 16; ++r) st[r] = 0.f;
#pragma unroll
        for (int s = 0; s < 4; ++s) st = __builtin_amdgcn_mfma_f32_32x32x16_bf16(kf[s], qf[s], st, 0, 0, 0);
#pragma unroll
        for (int r = 0; r < 16; ++r) { const int key = 32 * jb + (r & 3) + 8 * (r >> 2) + 4 * hi, dl = q - key;
            st[r] = dl >= 0 ? st[r] * __builtin_amdgcn_exp2f((float)dl * lg) : 0.f; }
        const bf16x8 pf0 = pack8(st[0], st[1], st[2], st[3], st[4], st[5], st[6], st[7]), pf1 = pack8(st[8], st[9], st[10], st[11], st[12], st[13], st[14], st[15]);
#pragma unroll
        for (int eb = 0; eb < 2; ++eb) {
            o[eb] = __builtin_amdgcn_mfma_f32_32x32x16_bf16(trfrag<true>(vimg + (2 * we + eb) * 8192, 32 * jb, lane), pf0, o[eb], 0, 0, 0);
            o[eb] = __builtin_amdgcn_mfma_f32_32x32x16_bf16(trfrag<true>(vimg + (2 * we + eb) * 8192, 32 * jb + 16, lane), pf1, o[eb], 0, 0, 0);
        }
    }
    float sm = 0.f, sq = 0.f;
#pragma unroll
    for (int r = 0; r < 16; ++r) { sm += o[0][r] + o[1][r]; sq += o[0][r] * o[0][r] + o[1][r] * o[1][r]; }
    sm += __shfl_xor(sm, 32); sq += __shfl_xor(sq, 32);
    if (hi == 0) { stat[(w * 32 + r32) * 2] = sm; stat[(w * 32 + r32) * 2 + 1] = sq; }
    __syncthreads();
    sm += stat[((w ^ 1) * 32 + r32) * 2]; sq += stat[((w ^ 1) * 32 + r32) * 2 + 1];
    const float mean = sm * (1.f / 128.f), var = sq * (1.f / 128.f) - mean * mean, rstd = 1.0f / sqrtf(fmaxf(var, 0.f) + EPS);
    const size_t grow = (R0 + q);
#pragma unroll
    for (int eb = 0; eb < 2; ++eb)
#pragma unroll
        for (int g = 0; g < 4; ++g) {
            const int e = 64 * we + 32 * eb + 8 * g + 4 * hi;
            const f32x4 gn = *(const f32x4*)(F_gain + h * 128 + e);
            const u32x2 sg = *(const u32x2*)(F_GR + grow * 512 + h * 128 + e);
            const float y0 = (o[eb][4 * g] - mean) * rstd * gn.x * bflo(sg.x), y1 = (o[eb][4 * g + 1] - mean) * rstd * gn.y * bfhi(sg.x);
            const float y2 = (o[eb][4 * g + 2] - mean) * rstd * gn.z * bflo(sg.y), y3 = (o[eb][4 * g + 3] - mean) * rstd * gn.w * bfhi(sg.y);
            u32x2 wv; wv.x = cvtpk(y0, y1); wv.y = cvtpk(y2, y3);
            *(u32x2*)(F_MIX + grow * D + 512 + h * 128 + e) = wv;
        }
    __syncthreads();
}
__device__ __forceinline__ void ret_sample_item(Frame& F, int sb, int h) {
    const int tid = F.tid;
    LAS float* q = (LAS float*)F.lds;
    LAS float* k = q + 512;
    LAS float* v = k + 512;
    LAS float* sg = v + 1024;
    LAS float* sc = sg + 1024;
    LAS float* ob = sc + 64;
    const size_t R0 = (size_t)MP + (size_t)sb * DT;
    const float lg = log2g_of(h);
    { const int i = tid >> 6, d = tid & 63; q[tid] = bf2f(F_QR[(R0 + i) * 256 + h * 64 + d]); k[tid] = bf2f(F_KR[(R0 + i) * 256 + h * 64 + d]); }
#pragma unroll
    for (int x = 0; x < 2; ++x) { const int id = tid + NTHREADS * x, i = id >> 7, e = id & 127; v[id] = bf2f(F_VR[(R0 + i) * 512 + h * 128 + e]); sg[id] = bf2f(F_GR[(R0 + i) * 512 + h * 128 + e]); }
    __syncthreads();
    if (tid < 64) { const int i = tid >> 3, j = tid & 7; float s = 0.f;
        for (int d = 0; d < 64; ++d) s += q[i * 64 + d] * k[j * 64 + d];
        sc[tid] = (i >= j) ? s * __builtin_amdgcn_exp2f((float)(i - j) * lg) : 0.f; }
    __syncthreads();
    const float* st0 = F_st + (size_t)(sb * 4 + h) * 8192;
    {
        const int e = tid & 127, ih = tid >> 7;
        float c0 = 0.f, c1 = 0.f;
        for (int d = 0; d < 64; ++d) { const float s0 = st0[d * 128 + e]; c0 += q[ih * 64 + d] * s0; c1 += q[(ih + 4) * 64 + d] * s0; }
        float i0 = 0.f, i1 = 0.f;
#pragma unroll
        for (int j = 0; j < 8; ++j) { i0 += sc[ih * 8 + j] * v[j * 128 + e]; i1 += sc[(ih + 4) * 8 + j] * v[j * 128 + e]; }
        ob[ih * 128 + e] = i0 + c0 * __builtin_amdgcn_exp2f((float)(ih + 1) * lg);
        ob[(ih + 4) * 128 + e] = i1 + c1 * __builtin_amdgcn_exp2f((float)(ih + 5) * lg);
    }
    {
        float* rs = F_out + OFF_RS + (size_t)(sb * 4 + h) * 8192; const float g8 = __builtin_amdgcn_exp2f(8.f * lg);
#pragma unroll
        for (int x = 0; x < 4; ++x) { const int gi = tid + NTHREADS * x, d = gi >> 5, e0 = (gi & 31) * 4;
            f32x4 s = *(const f32x4*)(st0 + d * 128 + e0) * g8;
#pragma unroll
            for (int j = 0; j < 8; ++j) { const float kd = k[j * 64 + d] * __builtin_amdgcn_exp2f((float)(7 - j) * lg); const f32x4 vv = *(const LAS f32x4*)(v + j * 128 + e0); s = s + vv * kd; }
            *(f32x4*)(rs + d * 128 + e0) = s; }
    }
    __syncthreads();
    { const int i = F.wave, lane = F.lane;
        const float a = ob[i * 128 + lane], b2 = ob[i * 128 + 64 + lane];
        const float mean = wave_sum(a + b2) * (1.f / 128.f);
        const float da = a - mean, db = b2 - mean; const float var = wave_sum(da * da + db * db) * (1.f / 128.f), rstd = 1.0f / sqrtf(var + EPS);
        bf16_t* mr = F_MIX + (R0 + i) * D + 512 + h * 128;
        mr[lane] = (bf16_t)f2bf(da * rstd * F_gain[h * 128 + lane] * sg[i * 128 + lane]);
        mr[64 + lane] = (bf16_t)f2bf(db * rstd * F_gain[h * 128 + 64 + lane] * sg[i * 128 + 64 + lane]); }
    __syncthreads();
}


#define XB_TMO      128
#define XB_XCNT(j)  (256  + 64 * (j))
#define XB_XSUB(j)  (1280 + 64 * (j))
#define XB_XGEN(j)  (2304 + 64 * (j))
#define XB_TOP      3328
#define XB_TOPGEN   3392
#define XCD_BAR_WORDS 3456
#define XB_SPIN_CAP (1u << 20)
__device__ __forceinline__ unsigned xb_ld(unsigned* p)              { return __hip_atomic_load(p, __ATOMIC_RELAXED, __HIP_MEMORY_SCOPE_AGENT); }
__device__ __forceinline__ unsigned xb_add(unsigned* p, unsigned v) { return __hip_atomic_fetch_add(p, v, __ATOMIC_RELAXED, __HIP_MEMORY_SCOPE_AGENT); }
__device__ __forceinline__ unsigned xb_xcc_id() { return (unsigned)__builtin_amdgcn_s_getreg((3 << 11) | 20) & 0xFu; }
#define XB_SPIN(cond, bar) do { unsigned _sp = 0; while (cond) { __builtin_amdgcn_s_sleep(1); \
    if ((++_sp & 255u) == 0u) { if (xb_ld(&(bar)[XB_TMO])) break; if (_sp > XB_SPIN_CAP) { atomicAdd(&(bar)[XB_TMO], 1u); break; } } } } while (0)
struct XcdBarrier { unsigned* bar; unsigned x; volatile LAS unsigned* st; };
__device__ __forceinline__ XcdBarrier xcd_barrier_post(unsigned* bar, volatile LAS unsigned* st) {
    XcdBarrier b; b.bar = bar; b.x = xb_xcc_id(); b.st = st;
    if (threadIdx.x == 0) (void)xb_add(&bar[XB_XCNT(b.x)], 1u);
    return b;
}
__device__ __forceinline__ void xcd_barrier_complete(unsigned* bar, unsigned x, unsigned& nloc, unsigned& nx) {
    const unsigned G = gridDim.x * gridDim.y * gridDim.z;
    unsigned sum, cnt, mine, sp = 0u;
    for (;;) {
        sum = 0u; cnt = 0u; mine = 0u;
#pragma unroll
        for (unsigned j = 0; j < 16; ++j) { const unsigned c = xb_ld(&bar[XB_XCNT(j)]); sum += c; cnt += (c > 0u) ? 1u : 0u; mine = (j == x) ? c : mine; }
        if (sum == G) break;
        __builtin_amdgcn_s_sleep(1);
        if ((++sp & 255u) == 0u) { if (xb_ld(&bar[XB_TMO])) break; if (sp > XB_SPIN_CAP) { atomicAdd(&bar[XB_TMO], 1u); break; } }
    }
    nloc = mine > 0u ? mine : 1u; nx = cnt > 0u ? cnt : 1u;
}
__device__ __forceinline__ void xcd_barrier(const XcdBarrier& b) {
    asm volatile("s_waitcnt vmcnt(0)" ::: "memory");
    __syncthreads();
    if (threadIdx.x == 0) {
        unsigned* bar = b.bar;
        __builtin_amdgcn_s_waitcnt(0);
        unsigned nloc = b.st[0], nx = b.st[1];
        if (nloc == 0u) { xcd_barrier_complete(bar, b.x, nloc, nx); b.st[0] = nloc; b.st[1] = nx; }
        const unsigned old = xb_add(&bar[XB_XSUB(b.x)], 1u);
        const unsigned gen = old / nloc;
        if (old + 1u == (gen + 1u) * nloc) {
            __builtin_amdgcn_fence(__ATOMIC_RELEASE, "agent");
            asm volatile("s_waitcnt vmcnt(0)" ::: "memory");
            const unsigned og = xb_add(&bar[XB_TOP], 1u);
            const unsigned tg = og / nx;
            if (og + 1u == (tg + 1u) * nx) xb_add(&bar[XB_TOPGEN], 1u);
            else XB_SPIN(xb_ld(&bar[XB_TOPGEN]) == tg, bar);
            __builtin_amdgcn_fence(__ATOMIC_ACQUIRE, "agent");
            xb_add(&bar[XB_XGEN(b.x)], 1u);
            asm volatile("s_waitcnt vmcnt(0)" ::: "memory");
        } else {
            XB_SPIN(xb_ld(&bar[XB_XGEN(b.x)]) == gen, bar);
            __builtin_amdgcn_fence(__ATOMIC_ACQUIRE, "agent");
            asm volatile("s_waitcnt vmcnt(0)" ::: "memory");
        }
    }
    __syncthreads();
}
constexpr int MISC_OFF = 131072 + 320;

constexpr int N_PHASES = 10;
__global__ void __launch_bounds__(NTHREADS, 2) fwd_kernel(Args args) {
    extern __shared__ __attribute__((aligned(16))) unsigned char lds_raw[];
    Frame F;
    F.lds = (LAS unsigned char*)lds_raw;
    F.tid = threadIdx.x; F.lane = F.tid & 63; F.wave = __builtin_amdgcn_readfirstlane(F.tid >> 6);
    F.G = gridDim.x; { const int bx = blockIdx.x; F.vcu = (F.G % 8 == 0) ? (bx % 8) * (F.G / 8) + bx / 8 : bx; }
    F.a = &args;
    const int lo = args.ph_lo, hi = args.ph_hi;
#ifndef PH_MASK
#define PH_MASK 0x3ff
#endif
#define IN(k) ((((PH_MASK) >> (k)) & 1) && lo <= (k) && (k) < hi)
#if MK_MULTI
#define SEAM(k) do { } while (0)
#elif MK_USE_CG
    cg::grid_group grid = cg::this_grid();
#define SEAM(k) do { if (IN(k) && IN((k) + 1)) grid.sync(); } while (0)
#else
    volatile LAS unsigned* MISC = (volatile LAS unsigned*)(F.lds + MISC_OFF);
    if (F.tid < 32) MISC[F.tid] = 0u;
    __syncthreads();
    XcdBarrier bar = xcd_barrier_post((unsigned*)(args.ws + WS_CTL), MISC + 8);
#define SEAM(k) do { if (IN(k) && IN((k) + 1)) xcd_barrier(bar); } while (0)
#endif
    if (IN(0)) p0_prologue(F);
    SEAM(0);
    if (IN(1)) norm_rows<0>(F);
    SEAM(1);
    if (IN(2)) {
        pg8::Gemm g{F_XN, F_WIN, M, NIN, D}; pg8::StaticOrder S; S.init(M, NIN, F.G, (int)blockIdx.x);
        pg8::EpiInProj E{F_QA, F_KA, F_VA, F_QR, F_KR, F_VR, F_GR, F_out, F_TABR, F_TABT};
        pg8::gemm_phase<pg8::EpiInProj, pg8::StaticOrder, true, true>(F.lds, g, S, E);
    }
    SEAM(2);
    if (IN(3)) {
        for (int it = 0; it < 2; ++it) {
            const int bh = F.vcu >> 2, qq = F.vcu & 3, rh = qq & 1, c = (qq >> 1) == 0 ? (it == 0 ? 0 : 3) : (it == 0 ? 1 : 2);
            if (F.vcu < 256) prompt_attn_tile(F, bh >> 3, bh & 7, 8 * rh + F.wave, c, F.lds + F.wave * 4096);
        }
        __syncthreads();
        for (int it = F.vcu; it < 512; it += F.G) ret_kv_item(F, it >> 6, (it >> 4) & 3, it & 15);
    }
    SEAM(3);
    if (IN(4)) {
        for (int it = F.vcu; it < 256; it += F.G) { const int bh = it >> 3, qq = it & 7;
            ret_out_item(F, bh >> 2, bh & 3, qq); ret_out_item(F, bh >> 2, bh & 3, 15 - qq); }
        for (int it = F.vcu; it < 256; it += F.G) sample_attn_item(F, it >> 3, it & 7);
        for (int it = F.vcu; it < 128; it += F.G) ret_sample_item(F, it >> 2, it & 3);
    }
    SEAM(4);
    if (IN(5)) {
        pg8::Gemm g{F_MIX, F_WOUT, M, D, D}; pg8::StaticOrder S; S.init(M, D, F.G, (int)blockIdx.x);
        pg8::EpiResid<true> E{F_xp, F_xs, F_X1, F_MOD + 2048, 6144};
        pg8::gemm_phase<pg8::EpiResid<true>, pg8::StaticOrder, true, true>(F.lds, g, S, E);
    }
    SEAM(5);
    if (IN(6)) norm_rows<1>(F);
    SEAM(6);
    if (IN(7)) {
        pg8::Gemm g{F_XN, F_W1, M, FF, D}; pg8::StaticOrder S; S.init(M, FF, F.G, (int)blockIdx.x);
        pg8::EpiRelu2 E{F_H, FF};
        pg8::gemm_phase<pg8::EpiRelu2, pg8::StaticOrder, true, true>(F.lds, g, S, E);
    }
    SEAM(7);
    if (IN(8)) {
        pg8::Gemm g{F_H, F_W2, M, D, FF}; pg8::StaticOrder S; S.init(M, D, F.G, (int)blockIdx.x);
        pg8::EpiResid<false> E{nullptr, nullptr, F_X1, F_MOD + 5120, 6144};
        pg8::gemm_phase<pg8::EpiResid<false>, pg8::StaticOrder, true, true>(F.lds, g, S, E);
    }
    SEAM(8);
    if (IN(9)) norm_rows<2>(F);
#undef IN
#undef SEAM
}

extern "C" void kernel_launch(void* const* d_in, const int* in_sizes, int n_in, void* d_out, int out_size, void* d_ws, size_t ws_size, hipStream_t stream) {
    static int grid = 0;
    if (grid == 0) {
        if (n_in != 16 || out_size != OUT_TOTAL || ws_size < WS_END) { fprintf(stderr, "kernel_launch: unexpected problem shape (n_in %d out %d ws %zu)\n", n_in, out_size, ws_size); grid = -1; return; }
        int dev = 0, cus = 0, per_cu = 0;
        if (hipGetDevice(&dev) != hipSuccess || hipDeviceGetAttribute(&cus, hipDeviceAttributeMultiprocessorCount, dev) != hipSuccess) { grid = -1; return; }
        if (hipFuncSetAttribute((const void*)fwd_kernel, hipFuncAttributeMaxDynamicSharedMemorySize, LDS_BYTES) != hipSuccess) { fprintf(stderr, "kernel_launch: hipFuncSetAttribute failed\n"); grid = -1; return; }
        if (hipOccupancyMaxActiveBlocksPerMultiprocessor(&per_cu, (const void*)fwd_kernel, NTHREADS, LDS_BYTES) != hipSuccess || per_cu < 1) { fprintf(stderr, "kernel_launch: occupancy query says %d\n", per_cu); per_cu = 1; }
        (void)hipGetLastError();
        grid = cus;
        if (grid > cus * per_cu) grid = cus * per_cu;
        if (grid != 256) fprintf(stderr, "kernel_launch: note: grid %d\n", grid);
    }
    if (grid < 0) return;
    if (hipMemsetAsync((char*)d_ws + WS_CTL, 0, 16384, stream) != hipSuccess) { fprintf(stderr, "kernel_launch: memset of the barrier words failed\n"); return; }
    Args a{};
    for (int i = 0; i < 16; ++i) a.in[i] = (const float*)d_in[i];
    a.out = (float*)d_out; a.ws = (unsigned char*)d_ws;
#if MK_MULTI
    for (int p = 0; p < N_PHASES; ++p) { a.ph_lo = p; a.ph_hi = p + 1; hipLaunchKernelGGL(fwd_kernel, dim3(grid), dim3(NTHREADS), LDS_BYTES, stream, a); }
#else
    a.ph_lo = 0; a.ph_hi = N_PHASES;
    void* kargs[] = {&a};
    hipError_t e = hipLaunchCooperativeKernel((const void*)fwd_kernel, dim3(grid), dim3(NTHREADS), kargs, LDS_BYTES, stream);
    if (e != hipSuccess) fprintf(stderr, "kernel_launch: cooperative launch failed: %s (grid %d)\n", hipGetErrorString(e), grid);
#endif
}
```

```cpp
#include <hip/hip_runtime.h>
#include <hip/hip_cooperative_groups.h>
#include <cstdio>
#include <cstdint>
namespace cg = cooperative_groups;

#ifndef MK_USE_CG
#define MK_USE_CG 0
#endif
#ifndef MK_MULTI
#define MK_MULTI 0
#endif

#define LAS __attribute__((address_space(3)))
#define GAS __attribute__((address_space(1)))
typedef unsigned short bf16_t;
typedef short bf16x8 __attribute__((ext_vector_type(8)));
typedef short s16x4 __attribute__((ext_vector_type(4)));
typedef float f32x2 __attribute__((ext_vector_type(2)));
typedef float f32x4 __attribute__((ext_vector_type(4)));
typedef float f32x16 __attribute__((ext_vector_type(16)));
typedef unsigned u32x2 __attribute__((ext_vector_type(2)));
typedef unsigned u32x4 __attribute__((ext_vector_type(4)));
typedef __bf16 bf16x2_t __attribute__((ext_vector_type(2)));

constexpr int D = 1024, SEQ = 2048, NB = 8, DBT = 32, DT = 8;
constexpr int MP = NB * SEQ, MS = DBT * DT, M = MP + MS;
constexpr int NIN = 3072, FF = 4096, NMODB = NB + DBT;
constexpr int LCACHE = 2048;
constexpr float EPS = 1e-6f;
constexpr float QSCALE = 0.125f * 1.4426950408889634f;
constexpr size_t OFF_Y = 0, OFF_KP = 17039360, OFF_VP = 25427968, OFF_RP = 33816576, OFF_KS = 34078720, OFF_VS = 34209792, OFF_RS = 34340864;
constexpr int OUT_TOTAL = 35389440;

constexpr size_t MiB = 1u << 20;
constexpr size_t WS_CTL = 0;
constexpr size_t WS_MOD = 1 * MiB;
constexpr size_t WS_MODF = WS_MOD + (size_t)NMODB * 6144 * 4;
constexpr size_t WS_TABR = 3 * MiB;
constexpr size_t WS_TABT = WS_TABR + 2056 * 8 * 8;
constexpr size_t WS_WIN = 4 * MiB;
constexpr size_t WS_WOUT = 10 * MiB;
constexpr size_t WS_W1 = 12 * MiB;
constexpr size_t WS_W2 = 20 * MiB;
constexpr size_t WS_XN = 28 * MiB;
constexpr size_t WS_QA = 61 * MiB;
constexpr size_t WS_KA = 78 * MiB;
constexpr size_t WS_VA = 95 * MiB;
constexpr size_t WS_QR = 112 * MiB;
constexpr size_t WS_KR = 121 * MiB;
constexpr size_t WS_VR = 130 * MiB;
constexpr size_t WS_GR = 147 * MiB;
constexpr size_t WS_MIX = 164 * MiB;
constexpr size_t WS_KV = 197 * MiB;
constexpr size_t WS_X1 = 214 * MiB;
constexpr size_t WS_H = 280 * MiB;
constexpr size_t WS_END = 411 * MiB;

constexpr int NWAVES = 8, NTHREADS = 512;
constexpr int LDS_BYTES = 147456;

__device__ const double INVF[40] = {
    1.0, 0.19392274474868576, 0.03760603093086393, 0.007292664737217109, 0.001414213562373095, 0.0002742481756762073, 5.318295896944988e-05, 1.031338537721246e-05,
    1.0, 0.7429639507594948, 0.551995432128157, 0.41011270705513014, 0.30469895709035083, 0.22638034095214482, 0.16819243248808696, 0.1249609141291987,
    0.09284145445194744, 0.06897785379387654, 0.05124805876960934, 0.038075460212223716, 0.028288694346259694, 0.021017480113324882, 0.015615230060004972,
    0.011601553017399714, 0.008619535664753033, 0.006404004271197283, 0.004757944314009409, 0.0035349811050301057, 0.0026263635276533325, 0.0019512934226359642,
    0.0014497406703726315, 0.001077105056036769, 0.0008002502278161052, 0.0005945570708544394, 0.00044173447031400687, 0.0003281927872511474,
    0.0002438354098268829, 0.00018116091942004152, 0.00013459603241553644, 0.0001};
__device__ __forceinline__ float log2g_of(int h) { return h == 0 ? -0.04580368961312479f : h == 1 ? -0.02272007650008353f : h == 2 ? -0.011315313227834146f : -0.005646563141142063f; }

__device__ __forceinline__ unsigned cvtpk(float lo, float hi) { f32x2 v = {lo, hi}; bf16x2_t b = __builtin_convertvector(v, bf16x2_t); return __builtin_bit_cast(unsigned, b); }
__device__ __forceinline__ float bf2f(unsigned short u) { return __uint_as_float((unsigned)u << 16); }
__device__ __forceinline__ float bflo(unsigned u) { return __uint_as_float(u << 16); }
__device__ __forceinline__ float bfhi(unsigned u) { return __uint_as_float(u & 0xffff0000u); }
__device__ __forceinline__ int row_bidx(int r) { return r < MP ? (r >> 11) : NB + ((r - MP) >> 3); }
__device__ __forceinline__ int row_tab(int r) { return r < MP ? (r & 2047) : 2048 + ((r - MP) & 7); }
__device__ __forceinline__ float wave_sum(float v) {
#pragma unroll
    for (int o = 1; o < 64; o <<= 1) v += __shfl_xor(v, o);
    return v;
}

namespace pg8 {
#define PG8_LAS __attribute__((address_space(3)))
constexpr int BM = 256, BK = 64, HALF = 128, HTB = HALF * BK * 2, STAGE_BYTES = 8 * HTB, NXCD = 8, WGM = 8;
__host__ __device__ __forceinline__ int lds_byte(int r, int c) { const int st = (r >> 4) * 2 + (c >> 5), rr = r & 15, cc = c & 31, ob = rr * 64 + cc * 2; return st * 1024 + (ob ^ (((ob >> 9) & 1) << 5)); }
__host__ __device__ __forceinline__ void stage_rc(int b, int& R, int& C) { const int st = b / 1024, sb = b % 1024, swz = sb ^ (((sb >> 9) & 1) << 5); R = (st >> 1) * 16 + swz / 64; C = (st & 1) * 32 + (swz % 64) / 2; }
__host__ __device__ __forceinline__ int perm32(int rho) { const int n = rho >> 4, i = rho & 15; return 8 * (i >> 2) + 4 * n + (i & 3); }
struct Unit { int pm, pn; };
struct Gemm { const bf16_t* A; const bf16_t* Bt; int M, N, K; };
struct StaticOrder {
    int nM, nN, nwg, G, c;
    __host__ __device__ void init(int M_, int N_, int G_, int c_) { nM = M_ / BM; nN = N_ / BM; nwg = nM * nN; G = G_; c = c_; }
    __host__ __device__ bool next(int i, Unit& u) const {
        const long L = (long)i * G + c; if (L >= nwg) return false;
        int wgid = (int)L; { const int q = nwg / NXCD, r = nwg % NXCD, xcd = wgid % NXCD, off = wgid / NXCD; wgid = (xcd < r ? xcd * (q + 1) : r * (q + 1) + (xcd - r) * q) + off; }
        const int nig = WGM * nN, gid = wgid / nig, fm = gid * WGM, gsz = (nM - fm) < WGM ? (nM - fm) : WGM;
        u.pm = fm + ((wgid % nig) % gsz); u.pn = (wgid % nig) / gsz; return true;
    }
    __device__ __forceinline__ void a_ready(const Unit&) const {}
    __device__ __forceinline__ void done(const Unit&) const {}
};

template <class Epi, class Sched, bool ALIGN_EPI = false, bool SP2 = false>
__device__ __forceinline__ void gemm_phase(PG8_LAS unsigned char* lds, const Gemm g, const Sched& S, const Epi& E) {
    const int tid = threadIdx.x, wid = __builtin_amdgcn_readfirstlane(tid >> 6), lane = tid & 63, wr = wid >> 2, wc = wid & 3, fr = lane & 15, fq = lane >> 4;
    const int K = g.K, nt = K / BK;
    unsigned voffA[2], voffB[2];
#pragma unroll
    for (int i = 0; i < 2; ++i) { int R, C; stage_rc(tid * 16 + i * 8192, R, C); const int Rb = Epi::PERM ? ((R & ~31) + perm32(R & 31)) : R;
        voffA[i] = (unsigned)(R * K + C) * 2u; voffB[i] = (unsigned)(Rb * K + C) * 2u; }
    const size_t kstep = (size_t)(BK * 2);
    const size_t hstep = (size_t)HALF * K * 2;
    const size_t tstep = 2 * hstep;
    const unsigned ldsw = (unsigned)wid * 1024u;
    const int aoff = lds_byte(wr * 64 + fr, fq * 8), boff = lds_byte(wc * 32 + fr, fq * 8);
#define PG8_SA(b, h) (((b) * 2 + (h)) * HTB)
#define PG8_SB(b, h) ((4 + (b) * 2 + (h)) * HTB)
#define PG8_STAGE(bufoff, gbase, voff) do { _Pragma("unroll") for (int _i = 0; _i < 2; ++_i) \
        __builtin_amdgcn_global_load_lds((const unsigned*)((const char*)(gbase) + (voff)[_i]), (PG8_LAS unsigned*)(lds + (bufoff) + ldsw + _i * 8192), 16, 0, 0); } while (0)
#define PG8_LDA(dst, b, h) do { _Pragma("unroll") for (int m = 0; m < 4; ++m) _Pragma("unroll") for (int k = 0; k < 2; ++k) dst[m][k] = *(const PG8_LAS bf16x8*)(lds + PG8_SA(b, h) + aoff + m * 2048 + k * 1024); } while (0)
#define PG8_LDB(dst, b, h) do { _Pragma("unroll") for (int n = 0; n < 2; ++n) _Pragma("unroll") for (int k = 0; k < 2; ++k) dst[n][k] = *(const PG8_LAS bf16x8*)(lds + PG8_SB(b, h) + boff + n * 2048 + k * 1024); } while (0)
#define PG8_MMA(ai, bj, At, Bt) do { __builtin_amdgcn_s_setprio(1); _Pragma("unroll") for (int m = 0; m < 4; ++m) _Pragma("unroll") for (int n = 0; n < 2; ++n) _Pragma("unroll") for (int k = 0; k < 2; ++k) \
        acc[ai][bj][m][n] = __builtin_amdgcn_mfma_f32_16x16x32_bf16(Bt[n][k], At[m][k], acc[ai][bj][m][n], 0, 0, 0); __builtin_amdgcn_s_setprio(0); } while (0)
#define PG8_WAIT_V(n) asm volatile("s_waitcnt vmcnt(" #n ")" ::: "memory")
#define PG8_WAIT_L(n) asm volatile("s_waitcnt lgkmcnt(" #n ")" ::: "memory")
#define PG8_BAR __builtin_amdgcn_s_barrier()
#define PG8_SCHED __builtin_amdgcn_sched_barrier(0)
    Unit cur, nxt; int ui = 0;
    if (!S.next(0, cur)) return;
    f32x4 acc[2][2][4][2];
#pragma unroll
    for (int a = 0; a < 2; ++a)
#pragma unroll
        for (int b = 0; b < 2; ++b)
#pragma unroll
            for (int m = 0; m < 4; ++m)
#pragma unroll
                for (int n = 0; n < 2; ++n) acc[a][b][m][n] = (f32x4){0.f, 0.f, 0.f, 0.f};
    bf16x8 At[4][2], B0[2][2], B1[2][2];
    const char* cA = (const char*)g.A + (size_t)cur.pm * tstep; const char* cB = (const char*)g.Bt + (size_t)cur.pn * tstep;
    S.a_ready(cur);
    if constexpr (SP2) {
        PG8_STAGE(PG8_SB(0, 0), cB, voffB); PG8_STAGE(PG8_SB(0, 1), cB + hstep, voffB); PG8_STAGE(PG8_SA(0, 0), cA, voffA); PG8_STAGE(PG8_SA(0, 1), cA + hstep, voffA);
        if (wr == 1) PG8_BAR;
        PG8_WAIT_V(2); PG8_BAR;
        PG8_STAGE(PG8_SB(1, 0), cB + kstep, voffB); PG8_STAGE(PG8_SA(1, 0), cA + kstep, voffA); PG8_STAGE(PG8_SB(1, 1), cB + hstep + kstep, voffB);
        PG8_WAIT_V(6); PG8_BAR;
    } else {
        PG8_STAGE(PG8_SB(0, 0), cB, voffB); PG8_STAGE(PG8_SA(0, 0), cA, voffA); PG8_STAGE(PG8_SB(0, 1), cB + hstep, voffB); PG8_STAGE(PG8_SA(0, 1), cA + hstep, voffA);
        if (wr == 1) PG8_BAR;
        PG8_WAIT_V(4); PG8_BAR;
        PG8_STAGE(PG8_SB(1, 0), cB + kstep, voffB); PG8_STAGE(PG8_SA(1, 0), cA + kstep, voffA); PG8_STAGE(PG8_SB(1, 1), cB + hstep + kstep, voffB);
        PG8_WAIT_V(6); PG8_BAR;
    }
    for (;;) {
        const bool has_next = S.next(ui + 1, nxt);
        const char* nA = has_next ? (const char*)g.A + (size_t)nxt.pm * tstep : cA; const char* nB = has_next ? (const char*)g.Bt + (size_t)nxt.pn * tstep : cB;
        for (int t = 0; t < nt; t += 2) {
            const bool last = (t == nt - 2);
            const char* a1 = cA + (size_t)(t + 1) * kstep;
            const char* a2 = last ? nA : cA + (size_t)(t + 2) * kstep; const char* b2 = last ? nB : cB + (size_t)(t + 2) * kstep;
            const char* a3 = a2 + kstep; const char* b3 = b2 + kstep;
            if (last && has_next) S.a_ready(nxt);
            if constexpr (SP2) {
            PG8_LDB(B0, 0, 0); PG8_LDB(B1, 0, 1); PG8_SCHED; PG8_LDA(At, 0, 0); PG8_STAGE(PG8_SA(1, 1), a1 + hstep, voffA);
            PG8_WAIT_V(8); PG8_WAIT_L(0); PG8_BAR; PG8_MMA(0, 0, At, B0); PG8_MMA(0, 1, At, B1); PG8_BAR; PG8_SCHED;
            PG8_LDA(At, 0, 1); PG8_STAGE(PG8_SB(0, 0), b2, voffB); PG8_STAGE(PG8_SB(0, 1), b2 + hstep, voffB); PG8_STAGE(PG8_SA(0, 0), a2, voffA);
            PG8_WAIT_V(8); PG8_WAIT_L(0); PG8_BAR; PG8_MMA(1, 0, At, B0); PG8_MMA(1, 1, At, B1); PG8_BAR; PG8_SCHED;
            PG8_LDB(B0, 1, 0); PG8_LDB(B1, 1, 1); PG8_SCHED; PG8_LDA(At, 1, 0); PG8_STAGE(PG8_SA(0, 1), a2 + hstep, voffA);
            PG8_WAIT_V(8); PG8_WAIT_L(0); PG8_BAR; PG8_MMA(0, 0, At, B0); PG8_MMA(0, 1, At, B1); PG8_BAR; PG8_SCHED;
            PG8_LDA(At, 1, 1); PG8_STAGE(PG8_SB(1, 0), b3, voffB); PG8_STAGE(PG8_SB(1, 1), b3 + hstep, voffB); PG8_STAGE(PG8_SA(1, 0), a3, voffA);
            PG8_WAIT_V(8); PG8_WAIT_L(0); PG8_BAR; PG8_MMA(1, 0, At, B0); PG8_MMA(1, 1, At, B1); PG8_BAR; PG8_SCHED;
            } else {
            PG8_LDB(B0, 0, 0); PG8_SCHED; PG8_LDA(At, 0, 0); PG8_STAGE(PG8_SA(1, 1), a1 + hstep, voffA);
            PG8_WAIT_L(8); PG8_BAR; PG8_WAIT_L(0); PG8_MMA(0, 0, At, B0); PG8_BAR; PG8_SCHED;
            PG8_LDB(B1, 0, 1); PG8_STAGE(PG8_SB(0, 0), b2, voffB);
            PG8_BAR; PG8_WAIT_L(0); PG8_MMA(0, 1, At, B1); PG8_BAR;
            PG8_LDA(At, 0, 1); PG8_STAGE(PG8_SA(0, 0), a2, voffA);
            PG8_BAR; PG8_WAIT_L(0); PG8_MMA(1, 0, At, B0); PG8_BAR; PG8_SCHED;
            PG8_STAGE(PG8_SB(0, 1), b2 + hstep, voffB);
            PG8_WAIT_V(6); PG8_BAR; PG8_MMA(1, 1, At, B1); PG8_BAR;
            PG8_LDB(B0, 1, 0); PG8_SCHED; PG8_LDA(At, 1, 0); PG8_STAGE(PG8_SA(0, 1), a2 + hstep, voffA);
            PG8_WAIT_L(8); PG8_BAR; PG8_WAIT_L(0); PG8_MMA(0, 0, At, B0); PG8_BAR; PG8_SCHED;
            PG8_LDB(B1, 1, 1); PG8_STAGE(PG8_SB(1, 0), b3, voffB);
            PG8_BAR; PG8_WAIT_L(0); PG8_MMA(0, 1, At, B1); PG8_BAR;
            PG8_LDA(At, 1, 1); PG8_STAGE(PG8_SA(1, 0), a3, voffA);
            PG8_BAR; PG8_WAIT_L(0); PG8_MMA(1, 0, At, B0); PG8_BAR; PG8_SCHED;
            PG8_STAGE(PG8_SB(1, 1), b3 + hstep, voffB);
            PG8_WAIT_V(6); PG8_BAR; PG8_MMA(1, 1, At, B1); PG8_BAR;
            }
        }
        if constexpr (ALIGN_EPI) { if (wr == 0) PG8_BAR; }
        E(acc, cur, wr, wc, fr, fq); S.done(cur);
        if (!has_next) break;
#pragma unroll
        for (int a = 0; a < 2; ++a)
#pragma unroll
            for (int b = 0; b < 2; ++b)
#pragma unroll
                for (int m = 0; m < 4; ++m)
#pragma unroll
                    for (int n = 0; n < 2; ++n) acc[a][b][m][n] = (f32x4){0.f, 0.f, 0.f, 0.f};
        cur = nxt; cA = nA; cB = nB; ++ui;
        if constexpr (ALIGN_EPI) { if (wr == 1) PG8_BAR; }
    }
    PG8_WAIT_V(0);
    if constexpr (!ALIGN_EPI) { if (wr == 0) PG8_BAR; }
    PG8_BAR;
#undef PG8_SA
#undef PG8_SB
#undef PG8_STAGE
#undef PG8_LDA
#undef PG8_LDB
#undef PG8_MMA
#undef PG8_WAIT_V
#undef PG8_WAIT_L
#undef PG8_BAR
#undef PG8_SCHED
}


struct EpiInProj {
    static constexpr bool PERM = false;
    bf16_t *QA, *KA, *VA, *QR, *KR, *VR, *GR; float* out; const f32x2* tabr; const f32x2* tabt;
    template <int TY> __device__ __forceinline__ void elem_t(int r, int col, f32x4 v, bool rope16, int fq) const {
        const int tp = row_tab(r);
        if constexpr (TY == 0 || TY == 1) {
            if (rope16) {
                const f32x2* tb = tabr + tp * 8 + (fq & 1) * 4;
#pragma unroll
                for (int e = 0; e < 4; ++e) { const float pv = __shfl_xor(v[e], 32); const f32x2 cs = tb[e];
                    v[e] = (fq < 2) ? (v[e] * cs.x - pv * cs.y) : (v[e] * cs.x + pv * cs.y); }
            }
            if constexpr (TY == 0) v = v * QSCALE;
        }
        if constexpr (TY == 3 || TY == 4) {
            const f32x2* tb = tabt + tp * 32 + ((col & 63) >> 1);
            const f32x2 c0 = tb[0], c1 = tb[1];
            const float a0 = v[0] * c0.x - v[1] * c0.y, a1 = v[1] * c0.x + v[0] * c0.y, a2 = v[2] * c1.x - v[3] * c1.y, a3 = v[3] * c1.x + v[2] * c1.y;
            v = (f32x4){a0, a1, a2, a3};
            if constexpr (TY == 4) v = v * 0.125f;
        }
        if constexpr (TY == 6) {
#pragma unroll
            for (int e = 0; e < 4; ++e) v[e] = v[e] / (1.0f + __builtin_amdgcn_exp2f(-1.4426950408889634f * v[e]));
        }
        if constexpr (TY == 1 || TY == 2) {
            float* o = out + (TY == 1 ? (r < MP ? OFF_KP : OFF_KS) : (r < MP ? OFF_VP : OFF_VS)) + (size_t)(r < MP ? r : r - MP) * 512 + col;
            *(f32x4*)o = v;
        }
        bf16_t* dst; int ld;
        if constexpr (TY == 0) { dst = QA; ld = 512; } else if constexpr (TY == 1) { dst = KA; ld = 512; } else if constexpr (TY == 2) { dst = VA; ld = 512; }
        else if constexpr (TY == 3) { dst = QR; ld = 256; } else if constexpr (TY == 4) { dst = KR; ld = 256; } else if constexpr (TY == 5) { dst = VR; ld = 512; } else { dst = GR; ld = 512; }
        u32x2 w; w.x = cvtpk(v[0], v[1]); w.y = cvtpk(v[2], v[3]);
        *(u32x2*)(dst + (size_t)r * ld + col) = w;
    }
    template <int TY> __device__ __forceinline__ void run(const f32x4 (&acc)[2][2][4][2], const Unit& u, int wr, int wc, int fr, int fq) const {
        const int cb = (TY <= 2 || TY >= 5) ? (u.pn & 1) * 256 : 0;
#pragma unroll
        for (int ai = 0; ai < 2; ++ai)
#pragma unroll
            for (int m = 0; m < 4; ++m) {
                const int r = u.pm * BM + ai * HALF + wr * 64 + m * 16 + fr;
#pragma unroll
                for (int bj = 0; bj < 2; ++bj)
#pragma unroll
                    for (int n = 0; n < 2; ++n) elem_t<TY>(r, cb + bj * HALF + wc * 32 + n * 16 + fq * 4, acc[ai][bj][m][n], n == 0 && (wc & 1) == 0, fq);
            }
    }
    __device__ __forceinline__ void operator()(const f32x4 (&acc)[2][2][4][2], const Unit& u, int wr, int wc, int fr, int fq) const {
        const int pn = u.pn;
        if (pn < 2) run<0>(acc, u, wr, wc, fr, fq);
        else if (pn < 4) run<1>(acc, u, wr, wc, fr, fq);
        else if (pn < 6) run<2>(acc, u, wr, wc, fr, fq);
        else if (pn == 6) run<3>(acc, u, wr, wc, fr, fq);
        else if (pn == 7) run<4>(acc, u, wr, wc, fr, fq);
        else if (pn < 10) run<5>(acc, u, wr, wc, fr, fq);
        else run<6>(acc, u, wr, wc, fr, fq);
    }
    __device__ __forceinline__ void elem(int r, int gc, f32x4 v, int fq) const {
        const int pn = __builtin_amdgcn_readfirstlane(gc >> 8); const bool rope16 = __builtin_amdgcn_readfirstlane(gc & 48) == 0;
        if (pn < 2) elem_t<0>(r, gc, v, rope16, fq);
        else if (pn < 4) elem_t<1>(r, gc - 512, v, rope16, fq);
        else if (pn < 6) elem_t<2>(r, gc - 1024, v, false, fq);
        else if (pn == 6) elem_t<3>(r, gc - 1536, v, false, fq);
        else if (pn == 7) elem_t<4>(r, gc - 1792, v, false, fq);
        else if (pn < 10) elem_t<5>(r, gc - 2048, v, false, fq);
        else elem_t<6>(r, gc - 2560, v, false, fq);
    }
};
template <bool FROM_X> struct EpiResid {
    static constexpr bool PERM = false;
    const float* xp; const float* xs; float* dst; const float* gate; int gld;
    __device__ __forceinline__ void elem(int r, int col, f32x4 v, int) const {
        const float* g = gate + (size_t)row_bidx(r) * gld;
        const float* base = FROM_X ? (r < MP ? xp + (size_t)r * D : xs + (size_t)(r - MP) * D) : dst + (size_t)r * D;
        const f32x4 b = *(const f32x4*)(base + col), gg = *(const f32x4*)(g + col);
        *(f32x4*)(dst + (size_t)r * D + col) = b + gg * v;
    }
    __device__ __forceinline__ void operator()(const f32x4 (&acc)[2][2][4][2], const Unit& u, int wr, int wc, int fr, int fq) const {
#pragma unroll
        for (int ai = 0; ai < 2; ++ai)
#pragma unroll
            for (int m = 0; m < 4; ++m) {
                const int r = u.pm * BM + ai * HALF + wr * 64 + m * 16 + fr;
#pragma unroll
                for (int bj = 0; bj < 2; ++bj)
#pragma unroll
                    for (int n = 0; n < 2; ++n) elem(r, u.pn * BM + bj * HALF + wc * 32 + n * 16 + fq * 4, acc[ai][bj][m][n], fq);
            }
    }
};
struct EpiRelu2 {
    static constexpr bool PERM = true;
    bf16_t* O; int ldc;
    __device__ __forceinline__ void elem(int r, int col, f32x4 v, int) const {
#pragma unroll
        for (int e = 0; e < 4; ++e) { const float a = fmaxf(v[e], 0.f); v[e] = a * a; }
        u32x2 w; w.x = cvtpk(v[0], v[1]); w.y = cvtpk(v[2], v[3]);
        *(u32x2*)(O + (size_t)r * ldc + col) = w;
    }
    __device__ __forceinline__ void operator()(const f32x4 (&acc)[2][2][4][2], const Unit& u, int wr, int wc, int fr, int fq) const {
        const int row0 = u.pm * BM + wr * 64 + fr, col0 = u.pn * BM + wc * 32 + 8 * fq;
#pragma unroll
        for (int ai = 0; ai < 2; ++ai)
#pragma unroll
            for (int m = 0; m < 4; ++m) { bf16_t* rowp = O + (size_t)(row0 + ai * HALF + m * 16) * ldc + col0;
#pragma unroll
                for (int bj = 0; bj < 2; ++bj) { f32x4 v0 = acc[ai][bj][m][0], v1 = acc[ai][bj][m][1];
#pragma unroll
                    for (int e = 0; e < 4; ++e) { const float a = fmaxf(v0[e], 0.f), b = fmaxf(v1[e], 0.f); v0[e] = a * a; v1[e] = b * b; }
                    u32x4 w; w.x = cvtpk(v0[0], v0[1]); w.y = cvtpk(v0[2], v0[3]); w.z = cvtpk(v1[0], v1[1]); w.w = cvtpk(v1[2], v1[3]);
                    *(u32x4*)(rowp + bj * HALF) = w; } }
    }
};

template <int NT, class Epi>
__device__ __forceinline__ void skinny_unit(PG8_LAS unsigned char* lds, const bf16_t* A, const bf16_t* Bt, int K, int mblk, int nblk, const Epi& E) {
    const int tid = threadIdx.x, w = __builtin_amdgcn_readfirstlane(tid >> 6), lane = tid & 63, fr = lane & 15, fq = lane >> 4;
    const int kw = K >> 3;
    f32x4 acc[4][NT];
#pragma unroll
    for (int mt = 0; mt < 4; ++mt)
#pragma unroll
        for (int nt = 0; nt < NT; ++nt) acc[mt][nt] = (f32x4){0.f, 0.f, 0.f, 0.f};
    const bf16_t* ap = A + (size_t)(mblk * 64 + fr) * K + w * kw + 8 * fq;
    const bf16_t* bp = Bt + (size_t)(nblk * 16 * NT + fr) * K + w * kw + 8 * fq;
#pragma unroll 2
    for (int ks = 0; ks < kw; ks += 32) {
        bf16x8 af[4], bfr[NT];
#pragma unroll
        for (int mt = 0; mt < 4; ++mt) af[mt] = *(const bf16x8*)(ap + (size_t)mt * 16 * K + ks);
#pragma unroll
        for (int nt = 0; nt < NT; ++nt) bfr[nt] = *(const bf16x8*)(bp + (size_t)nt * 16 * K + ks);
#pragma unroll
        for (int mt = 0; mt < 4; ++mt)
#pragma unroll
            for (int nt = 0; nt < NT; ++nt) acc[mt][nt] = __builtin_amdgcn_mfma_f32_16x16x32_bf16(bfr[nt], af[mt], acc[mt][nt], 0, 0, 0);
    }
    PG8_LAS f32x4* red = (PG8_LAS f32x4*)lds;
#pragma unroll
    for (int mt = 0; mt < 4; ++mt)
#pragma unroll
        for (int nt = 0; nt < NT; ++nt) red[((w * 4 + mt) * NT + nt) * 64 + lane] = acc[mt][nt];
    __syncthreads();
    for (int t = w; t < 4 * NT; t += 8) { const int mt = t / NT, nt = t % NT;
        f32x4 v = red[(mt * NT + nt) * 64 + lane];
#pragma unroll
        for (int ww = 1; ww < 8; ++ww) v = v + red[((ww * 4 + mt) * NT + nt) * 64 + lane];
        E.elem(MP + mblk * 64 + mt * 16 + fr, (nblk * NT + nt) * 16 + 4 * fq, v, fq);
    }
    __syncthreads();
}
template <int NT, class Epi>
__device__ __forceinline__ void skinny_gemm(PG8_LAS unsigned char* lds, const bf16_t* Asample, const bf16_t* Bt, int N, int K, int first, int G, const Epi& E) {
    const int ncol = N / (16 * NT), nunits = 4 * ncol;
    for (int u = first; u < nunits; u += G) skinny_unit<NT, Epi>(lds, Asample, Bt, K, u / ncol, u % ncol, E);
}
}

struct Args { const float* in[16]; float* out; unsigned char* ws; int ph_lo, ph_hi; };
struct Frame {
    LAS unsigned char* lds;
    int tid, lane, wave, vcu, G;
    const Args* a;
#define FIN(i) ((const float*)F.a->in[i])
#define FWS(T, off) ((T*)(F.a->ws + (off)))
};
#define F_xp FIN(0)
#define F_xs FIN(1)
#define F_cp FIN(2)
#define F_cs FIN(3)
#define F_ck FIN(4)
#define F_cv FIN(5)
#define F_st FIN(6)
#define F_w_ada FIN(7)
#define F_b_ada FIN(8)
#define F_w_in FIN(9)
#define F_gain FIN(10)
#define F_w_out FIN(11)
#define F_w_ff1 FIN(12)
#define F_w_ff2 FIN(13)
#define F_w_adaf FIN(14)
#define F_b_adaf FIN(15)
#define F_out (F.a->out)
#define F_MOD FWS(float, WS_MOD)
#define F_MODF FWS(float, WS_MODF)
#define F_TABR FWS(f32x2, WS_TABR)
#define F_TABT FWS(f32x2, WS_TABT)
#define F_WIN FWS(bf16_t, WS_WIN)
#define F_WOUT FWS(bf16_t, WS_WOUT)
#define F_W1 FWS(bf16_t, WS_W1)
#define F_W2 FWS(bf16_t, WS_W2)
#define F_XN FWS(bf16_t, WS_XN)
#define F_QA FWS(bf16_t, WS_QA)
#define F_KA FWS(bf16_t, WS_KA)
#define F_VA FWS(bf16_t, WS_VA)
#define F_QR FWS(bf16_t, WS_QR)
#define F_KR FWS(bf16_t, WS_KR)
#define F_VR FWS(bf16_t, WS_VR)
#define F_GR FWS(bf16_t, WS_GR)
#define F_MIX FWS(bf16_t, WS_MIX)
#define F_H FWS(bf16_t, WS_H)
#define F_KV FWS(float, WS_KV)
#define F_X1 FWS(float, WS_X1)

__device__ __forceinline__ unsigned f2bf(float f) { unsigned u = __builtin_bit_cast(unsigned, f); return (u + 0x7fffu + ((u >> 16) & 1u)) >> 16; }
__device__ __forceinline__ unsigned pk2(float lo, float hi) { return f2bf(lo) | (f2bf(hi) << 16); }
__device__ __forceinline__ void p0_transpose_item(const float* W, int K, int N, bf16_t* WT, LAS float* scr, int item, int lane) {
    const int nblk = N / 32, kb = item / nblk, nb = item % nblk, k0 = 64 * kb, n0 = 32 * nb;
#pragma unroll 8
    for (int i = 0; i < 32; ++i) { const int kk = 2 * i + (lane >> 5); scr[kk * 33 + (lane & 31)] = W[(size_t)(k0 + kk) * N + n0 + (lane & 31)]; }
    asm volatile("s_waitcnt lgkmcnt(0)" ::: "memory");
    const int c = lane & 7;
#pragma unroll
    for (int j = 0; j < 4; ++j) { const int n = (lane >> 3) + 8 * j; const LAS float* s = scr + (8 * c) * 33 + n;
        u32x4 o; o.x = pk2(s[0 * 33], s[1 * 33]); o.y = pk2(s[2 * 33], s[3 * 33]); o.z = pk2(s[4 * 33], s[5 * 33]); o.w = pk2(s[6 * 33], s[7 * 33]);
        *(u32x4*)(WT + (size_t)(n0 + n) * K + k0 + 8 * c) = o; }
    asm volatile("s_waitcnt lgkmcnt(0)" ::: "memory");
}
__device__ __forceinline__ void sincos_d(double x, float& sn, float& cs) {
    const double k = __builtin_rint(x * 0.63661977236758134308);
    double r = __builtin_fma(-k, 1.57079632679489655800e+00, x); r = __builtin_fma(-k, 6.12323399573676603587e-17, r);
    const double r2 = r * r;
    double s = -7.6471637318198164759e-13; s = s * r2 + 1.6059043836821614599e-10; s = s * r2 - 2.5052108385441718775e-08; s = s * r2 + 2.7557319223985890653e-06;
    s = s * r2 - 1.9841269841269841270e-04; s = s * r2 + 8.3333333333333333333e-03; s = s * r2 - 1.6666666666666666667e-01; s = r + r * r2 * s;
    double c = 4.7794773323873852974e-14; c = c * r2 - 1.1470745597729724714e-11; c = c * r2 + 2.0876756987868098979e-09; c = c * r2 - 2.7557319223985890653e-07;
    c = c * r2 + 2.4801587301587301587e-05; c = c * r2 - 1.3888888888888888889e-03; c = c * r2 + 4.1666666666666666667e-02; c = c * r2 - 0.5; c = 1.0 + r2 * c;
    const int q = ((int)k) & 3;
    const double ss = (q == 0) ? s : (q == 1) ? c : (q == 2) ? -s : -c;
    const double cc = (q == 0) ? c : (q == 1) ? -s : (q == 2) ? -c : s;
    sn = (float)ss; cs = (float)cc;
}
__device__ __forceinline__ void p0_prologue(Frame& F) {
    {
        const int w = F.wave, lane = F.lane, hh = lane >> 5, cl = lane & 31;
        LAS float* sst = (LAS float*)(F.lds + w * 16384);
        for (int item = F.vcu; item < 256; item += F.G) {
            const bool fin = item >= 192; const int col = (fin ? item - 192 : item) * 32 + cl;
            const float* W = fin ? F_w_adaf : F_w_ada; const int ldw = fin ? 2048 : 6144;
            float acc[NMODB];
#pragma unroll
            for (int r = 0; r < NMODB; ++r) acc[r] = 0.f;
            for (int sub = 0; sub < 4; ++sub) {
                const int kb = 128 * w + 16 * sub;
#pragma unroll 4
                for (int i = 0; i < 20; ++i) { const int idx = lane + 64 * i, h2 = idx / 640, rem = idx % 640, r = rem >> 4, kk = rem & 15, k = kb + 64 * h2 + kk;
                    const float c = r < NB ? F_cp[r * D + k] : F_cs[(r - NB) * D + k];
                    sst[idx] = c / (1.0f + __expf(-c)); }
                asm volatile("s_waitcnt lgkmcnt(0)" ::: "memory");
#pragma unroll 1
                for (int k4 = 0; k4 < 4; ++k4) {
                    const int k = kb + 64 * hh + 4 * k4;
                    const float w0 = W[(size_t)(k + 0) * ldw + col], w1 = W[(size_t)(k + 1) * ldw + col], w2 = W[(size_t)(k + 2) * ldw + col], w3 = W[(size_t)(k + 3) * ldw + col];
#pragma unroll
                    for (int r = 0; r < NMODB; ++r) { const f32x4 s4 = *(const LAS f32x4*)(sst + hh * 640 + r * 16 + 4 * k4);
                        acc[r] += s4.x * w0 + s4.y * w1 + s4.z * w2 + s4.w * w3;
                        if ((r & 7) == 7) __builtin_amdgcn_sched_barrier(0); }
                }
                asm volatile("s_waitcnt lgkmcnt(0)" ::: "memory");
            }
            __syncthreads();
            LAS float* red = (LAS float*)F.lds;
#pragma unroll
            for (int r = 0; r < NMODB; ++r) red[((2 * w + hh) * NMODB + r) * 32 + cl] = acc[r];
            __syncthreads();
            for (int o = F.tid; o < NMODB * 32; o += NTHREADS) { const int r = o >> 5, c2 = o & 31; float s = 0.f;
#pragma unroll
                for (int p = 0; p < 16; ++p) s += red[(p * NMODB + r) * 32 + c2];
                const int oc = (fin ? item - 192 : item) * 32 + c2;
                if (fin) F_MODF[r * 2048 + oc] = s + F_b_adaf[oc]; else F_MOD[r * 6144 + oc] = s + F_b_ada[oc]; }
            __syncthreads();
        }
    }
    {
        LAS float* scr = (LAS float*)(F.lds + F.wave * 16384);
        const int gw = F.vcu * NWAVES + F.wave, NGW = F.G * NWAVES;
        constexpr int I_IN = (D / 64) * (NIN / 32), I_O = (D / 64) * (D / 32), I_1 = (D / 64) * (FF / 32), I_2 = (FF / 64) * (D / 32);
        constexpr int NITEMS = I_IN + I_O + I_1 + I_2;
        for (int it = gw; it < NITEMS; it += NGW) {
            int r = it;
            if (r < I_IN) { p0_transpose_item(F_w_in, D, NIN, F_WIN, scr, r, F.lane); continue; } r -= I_IN;
            if (r < I_O) { p0_transpose_item(F_w_out, D, D, F_WOUT, scr, r, F.lane); continue; } r -= I_O;
            if (r < I_1) { p0_transpose_item(F_w_ff1, D, FF, F_W1, scr, r, F.lane); continue; } r -= I_1;
            p0_transpose_item(F_w_ff2, FF, D, F_W2, scr, r, F.lane);
        }
    }
    {
        const int gt = F.vcu * NTHREADS + F.tid, NT = F.G * NTHREADS;
        for (int i = gt; i < 2056 * 40; i += NT) { const int p = i / 40, j = i % 40; const int pos = p < 2048 ? p : 8192 + (p - 2048);
            float sn, cs; sincos_d((double)pos * INVF[j], sn, cs);
            if (j < 8) F_TABR[p * 8 + j] = (f32x2){cs, sn}; else F_TABT[p * 32 + (j - 8)] = (f32x2){cs, sn}; }
    }
}

template <int MODE> __device__ __forceinline__ void norm_rows(Frame& F) {
    const int gw = F.vcu * NWAVES + F.wave, NGW = F.G * NWAVES;
    for (int m = gw; m < M; m += NGW) {
        const float* xrow = MODE == 0 ? (m < MP ? F_xp + (size_t)m * D : F_xs + (size_t)(m - MP) * D) : F_X1 + (size_t)m * D;
        const f32x4* xr = (const f32x4*)xrow + F.lane;
        f32x4 v[4]; float s = 0.f;
#pragma unroll
        for (int j = 0; j < 4; ++j) { v[j] = xr[64 * j]; s += (v[j].x * v[j].x + v[j].y * v[j].y) + (v[j].z * v[j].z + v[j].w * v[j].w); }
        const float rstd = 1.0f / sqrtf(wave_sum(s) * (1.f / D) + EPS);
        const int bi = row_bidx(m);
        const float* shp = MODE == 0 ? F_MOD + (size_t)bi * 6144 : MODE == 1 ? F_MOD + (size_t)bi * 6144 + 3072 : F_MODF + (size_t)bi * 2048;
        const float* scp = shp + 1024;
#pragma unroll
        for (int j = 0; j < 4; ++j) {
            const f32x4 sh = ((const f32x4*)shp)[F.lane + 64 * j], sc = ((const f32x4*)scp)[F.lane + 64 * j];
            const f32x4 o = v[j] * rstd * (sc + 1.0f) + sh;
            if constexpr (MODE == 2) ((f32x4*)(F_out + OFF_Y + (size_t)m * D))[F.lane + 64 * j] = o;
            else { u32x2 w; w.x = cvtpk(o.x, o.y); w.y = cvtpk(o.z, o.w); ((u32x2*)(F_XN + (size_t)m * D))[F.lane + 64 * j] = w; }
        }
    }
}

typedef short v4i16_t __attribute__((ext_vector_type(4)));
template <bool PERMK> __device__ __forceinline__ bf16x8 trfrag(LAS const unsigned char* img, int k0, int lane) {
    const int hi = lane >> 5, gb = (lane >> 4) & 1, q = (lane >> 2) & 3, p = lane & 3;
    const int ra = PERMK ? (k0 + 4 * hi + q) : (k0 + 8 * hi + q), rb = PERMK ? (ra + 8) : (ra + 4);
    LAS const unsigned char* pa = img + ra * 64 + (16 * gb + 4 * p) * 2; LAS const unsigned char* pb = img + rb * 64 + (16 * gb + 4 * p) * 2;
    const s16x4 lo = __builtin_bit_cast(s16x4, __builtin_amdgcn_ds_read_tr16_b64_v4i16((LAS v4i16_t*)pa));
    const s16x4 h4 = __builtin_bit_cast(s16x4, __builtin_amdgcn_ds_read_tr16_b64_v4i16((LAS v4i16_t*)pb));
    return (bf16x8){lo[0], lo[1], lo[2], lo[3], h4[0], h4[1], h4[2], h4[3]};
}
__device__ __forceinline__ bf16x8 pack8(float a0, float a1, float a2, float a3, float a4, float a5, float a6, float a7) {
    u32x4 w; w.x = cvtpk(a0, a1); w.y = cvtpk(a2, a3); w.z = cvtpk(a4, a5); w.w = cvtpk(a6, a7); return __builtin_bit_cast(bf16x8, w);
}
__device__ __forceinline__ bf16x8 ld8_bf16(const bf16_t* p) { return *(const bf16x8*)p; }
__device__ __forceinline__ bf16x8 ld8_f32(const float* p) { const f32x4 a = *(const f32x4*)p, b = *(const f32x4*)(p + 4); return pack8(a.x, a.y, a.z, a.w, b.x, b.y, b.z, b.w); }

struct AttnAcc { f32x16 o0, o1; float m, l; };
template <int BR, bool EXCL, bool QMASK>
__device__ __forceinline__ void attn_step(AttnAcc& A, const bf16x8 (&kf)[4], const bf16x8 (&qf)[4], LAS const unsigned char* vimg, int qp, bool qvalid, int p0, int s_hi, int s_lo, int lane) {
    const int hi = lane >> 5;
    f32x16 s = {0.f, 0.f, 0.f, 0.f, 0.f, 0.f, 0.f, 0.f, 0.f, 0.f, 0.f, 0.f, 0.f, 0.f, 0.f, 0.f};
#pragma unroll
    for (int d0 = 0; d0 < 4; ++d0) s = __builtin_amdgcn_mfma_f32_32x32x16_bf16(kf[d0], qf[d0], s, 0, 0, 0);
    const int pbase = p0 + 4 * hi * s_lo, dbase = qp - pbase;
    float mu[16]; float tmax = -1e30f;
#pragma unroll
    for (int r = 0; r < 16; ++r) {
        const int off = (r >> 2) * s_hi + (r & 3) * s_lo, dist = dbase - off, pos = pbase + off;
        int ml = 0;
        if (BR & 1) ml += (dist <= 128) ? 1 : 0;
        if (BR & 2) ml += ((dist & 3) == 0 && dist <= 512) ? 1 : 0;
        if (BR & 4) ml += ((dist & 15) == 0 && dist <= 2048) ? 1 : 0;
        if (EXCL && (dist & 15) == 0) ml = 0;
        if (dist < 0 || pos < 0) ml = 0;
        if (QMASK && !qvalid) ml = 0;
        mu[r] = (float)ml;
        s[r] = ml ? s[r] : -1e30f; tmax = fmaxf(tmax, s[r]);
    }
    tmax = fmaxf(tmax, __shfl_xor(tmax, 32));
    const float mn = fmaxf(A.m, tmax), alpha = __builtin_amdgcn_exp2f(A.m - mn); A.m = mn;
    float ps = 0.f;
#pragma unroll
    for (int r = 0; r < 16; ++r) { s[r] = mu[r] * __builtin_amdgcn_exp2f(s[r] - mn); ps += s[r]; }
    A.l = A.l * alpha + ps;
    A.o0 = A.o0 * alpha; A.o1 = A.o1 * alpha;
    const bf16x8 pf0 = pack8(s[0], s[1], s[2], s[3], s[4], s[5], s[6], s[7]), pf1 = pack8(s[8], s[9], s[10], s[11], s[12], s[13], s[14], s[15]);
    A.o0 = __builtin_amdgcn_mfma_f32_32x32x16_bf16(trfrag<true>(vimg, 0, lane), pf0, A.o0, 0, 0, 0);
    A.o0 = __builtin_amdgcn_mfma_f32_32x32x16_bf16(trfrag<true>(vimg, 16, lane), pf1, A.o0, 0, 0, 0);
    A.o1 = __builtin_amdgcn_mfma_f32_32x32x16_bf16(trfrag<true>(vimg + 2048, 0, lane), pf0, A.o1, 0, 0, 0);
    A.o1 = __builtin_amdgcn_mfma_f32_32x32x16_bf16(trfrag<true>(vimg + 2048, 16, lane), pf1, A.o1, 0, 0, 0);
}
template <bool F32SRC> struct TileRegs { bf16x8 kf[4]; bf16x8 vs[4]; };
template <bool F32SRC> __device__ __forceinline__ void tile_load(TileRegs<F32SRC>& T, const void* kb, const void* vb, long rowbase, int pmax, int p0, int s_hi, int s_lo, int lane) {
    const int r32 = lane & 31, hi = lane >> 5;
    int pk = p0 + (r32 >> 3) * s_hi + (r32 & 7) * s_lo; pk = pk < 0 ? 0 : (pk > pmax ? pmax : pk);
    const int kv = lane >> 1; int pv = p0 + (kv >> 3) * s_hi + (kv & 7) * s_lo; pv = pv < 0 ? 0 : (pv > pmax ? pmax : pv);
    if constexpr (F32SRC) {
        const float* kr = (const float*)kb + (rowbase + pk) * 512 + 8 * hi; const float* vr = (const float*)vb + (rowbase + pv) * 512 + 32 * (lane & 1);
#pragma unroll
        for (int d0 = 0; d0 < 4; ++d0) T.kf[d0] = ld8_f32(kr + 16 * d0);
#pragma unroll
        for (int j = 0; j < 4; ++j) T.vs[j] = ld8_f32(vr + 8 * j);
    } else {
        const bf16_t* kr = (const bf16_t*)kb + (rowbase + pk) * 512 + 8 * hi; const bf16_t* vr = (const bf16_t*)vb + (rowbase + pv) * 512 + 32 * (lane & 1);
#pragma unroll
        for (int d0 = 0; d0 < 4; ++d0) T.kf[d0] = ld8_bf16(kr + 16 * d0);
#pragma unroll
        for (int j = 0; j < 4; ++j) T.vs[j] = ld8_bf16(vr + 8 * j);
    }
}
template <bool F32SRC> __device__ __forceinline__ void tile_stage_v(const TileRegs<F32SRC>& T, LAS unsigned char* vimg, int lane) {
    LAS unsigned char* d = vimg + (lane & 1) * 2048 + (lane >> 1) * 64;
#pragma unroll
    for (int j = 0; j < 4; ++j) *(LAS bf16x8*)(d + 16 * j) = T.vs[j];
}
__device__ __forceinline__ void attn_store(const AttnAcc& A, bf16_t* mixrow, int lane) {
    const int hi = lane >> 5;
    const float lt = A.l + __shfl_xor(A.l, 32), inv = 1.0f / lt;
#pragma unroll
    for (int g = 0; g < 4; ++g) {
        u32x2 w0, w1; w0.x = cvtpk(A.o0[4 * g] * inv, A.o0[4 * g + 1] * inv); w0.y = cvtpk(A.o0[4 * g + 2] * inv, A.o0[4 * g + 3] * inv);
        w1.x = cvtpk(A.o1[4 * g] * inv, A.o1[4 * g + 1] * inv); w1.y = cvtpk(A.o1[4 * g + 2] * inv, A.o1[4 * g + 3] * inv);
        *(u32x2*)(mixrow + 8 * g + 4 * hi) = w0; *(u32x2*)(mixrow + 32 + 8 * g + 4 * hi) = w1;
    }
}
#define WAVE_LDS_FENCE() asm volatile("s_waitcnt lgkmcnt(0)" ::: "memory")

__device__ __forceinline__ void prompt_attn_tile(Frame& F, int b, int h, int rho, int c, LAS unsigned char* vimg) {
    const int lane = F.lane, r32 = lane & 31, hi = lane >> 5;
    const int T0 = 512 * c + rho, qp = T0 + 16 * r32;
    const long rowbase = (long)b * SEQ;
    const bf16_t* Qp = F_QA + h * 64; const bf16_t* Kp = F_KA + h * 64; const bf16_t* Vp = F_VA + h * 64;
    bf16x8 qf[4];
#pragma unroll
    for (int d0 = 0; d0 < 4; ++d0) qf[d0] = ld8_bf16(Qp + (rowbase + qp) * 512 + 16 * d0 + 8 * hi);
    AttnAcc A; A.m = -1e30f; A.l = 0.f;
#pragma unroll
    for (int r = 0; r < 16; ++r) { A.o0[r] = 0.f; A.o1[r] = 0.f; }
    TileRegs<false> T;
    for (int ti = 0; ti < 5; ++ti) { const int p0 = T0 - 2048 + 512 * ti; if (p0 + 496 < 0) continue;
        tile_load<false>(T, Kp, Vp, rowbase, SEQ - 1, p0, 128, 16, lane); tile_stage_v<false>(T, vimg, lane); WAVE_LDS_FENCE();
        attn_step<7, false, false>(A, T.kf, qf, vimg, qp, true, p0, 128, 16, lane); WAVE_LDS_FENCE(); }
    for (int ti = 0; ti < 3; ++ti) { const int p0 = T0 - 512 + 128 * ti; if (p0 + 124 < 0) continue;
        tile_load<false>(T, Kp, Vp, rowbase, SEQ - 1, p0, 32, 4, lane); tile_stage_v<false>(T, vimg, lane); WAVE_LDS_FENCE();
        attn_step<7, true, false>(A, T.kf, qf, vimg, qp, true, p0, 32, 4, lane); WAVE_LDS_FENCE(); }
    for (int ti = 0; ti < 20; ++ti) { const int p0 = T0 - 128 + 32 * ti; if (p0 + 31 < 0 || p0 > SEQ - 1) continue;
        tile_load<false>(T, Kp, Vp, rowbase, SEQ - 1, p0, 8, 1, lane); tile_stage_v<false>(T, vimg, lane); WAVE_LDS_FENCE();
        attn_step<7, true, false>(A, T.kf, qf, vimg, qp, true, p0, 8, 1, lane); WAVE_LDS_FENCE(); }
    attn_store(A, F_MIX + (rowbase + qp) * D + h * 64, lane);
}

__device__ __forceinline__ void sample_attn_item(Frame& F, int sb, int h) {
    const int lane = F.lane, r32 = lane & 31, hi = lane >> 5, w = F.wave;
    LAS unsigned char* vimg = F.lds + w * 4096;
    const bool qvalid = r32 < DT; const int qp = LCACHE + (qvalid ? r32 : 0);
    bf16x8 qf[4];
#pragma unroll
    for (int d0 = 0; d0 < 4; ++d0) qf[d0] = ld8_bf16(F_QA + (size_t)(MP + sb * DT + (qvalid ? r32 : 0)) * 512 + h * 64 + 16 * d0 + 8 * hi);
    AttnAcc A; A.m = -1e30f; A.l = 0.f;
#pragma unroll
    for (int r = 0; r < 16; ++r) { A.o0[r] = 0.f; A.o1[r] = 0.f; }
    for (int ti = w; ti < 41; ti += NWAVES) {
        if (ti == 0) {
            TileRegs<false> T; tile_load<false>(T, F_KA + h * 64, F_VA + h * 64, (long)(MP + sb * DT) - LCACHE, LCACHE + DT - 1, LCACHE, 8, 1, lane);
            tile_stage_v<false>(T, vimg, lane); WAVE_LDS_FENCE();
            attn_step<7, false, true>(A, T.kf, qf, vimg, qp, qvalid, LCACHE, 8, 1, lane); WAVE_LDS_FENCE();
        } else {
            const int p0 = ti <= 16 ? (LCACHE - 512 + 32 * (ti - 1)) : 64 * (ti - 17); const int s_hi = ti <= 16 ? 8 : 16;
            TileRegs<true> T; tile_load<true>(T, F_ck + h * 64, F_cv + h * 64, (long)sb * LCACHE, LCACHE - 1, p0, s_hi, 1, lane);
            tile_stage_v<true>(T, vimg, lane); WAVE_LDS_FENCE();
            attn_step<7, false, true>(A, T.kf, qf, vimg, qp, qvalid, p0, s_hi, 1, lane); WAVE_LDS_FENCE();
        }
    }
    LAS float* po = (LAS float*)(F.lds + 32768); LAS float* pm = po + 8 * 8 * 64; LAS float* pl = pm + 64;
    const float lt = A.l + __shfl_xor(A.l, 32);
    if (qvalid) {
#pragma unroll
        for (int g = 0; g < 4; ++g) {
            *(LAS f32x4*)(po + (w * 8 + r32) * 64 + 8 * g + 4 * hi) = (f32x4){A.o0[4 * g], A.o0[4 * g + 1], A.o0[4 * g + 2], A.o0[4 * g + 3]};
            *(LAS f32x4*)(po + (w * 8 + r32) * 64 + 32 + 8 * g + 4 * hi) = (f32x4){A.o1[4 * g], A.o1[4 * g + 1], A.o1[4 * g + 2], A.o1[4 * g + 3]};
        }
        if (hi == 0) { pm[w * 8 + r32] = A.m; pl[w * 8 + r32] = lt; }
    }
    __syncthreads();
    {
        const int q = F.tid >> 6, d = F.tid & 63;
        float mm = -1e30f;
#pragma unroll
        for (int ww = 0; ww < 8; ++ww) mm = fmaxf(mm, pm[ww * 8 + q]);
        float L = 0.f, O = 0.f;
#pragma unroll
        for (int ww = 0; ww < 8; ++ww) { const float f = __builtin_amdgcn_exp2f(pm[ww * 8 + q] - mm); L += pl[ww * 8 + q] * f; O += po[(ww * 8 + q) * 64 + d] * f; }
        const float o = O / L;
        F_MIX[(size_t)(MP + sb * DT + q) * D + h * 64 + d] = (bf16_t)f2bf(o);
    }
    __syncthreads();
}

__device__ __forceinline__ void ret_kv_item(Frame& F, int b, int h, int j) {
    const int tid = F.tid, lane = F.lane, w = F.wave;
    LAS unsigned char* kimg = F.lds;
    LAS unsigned char* vimg = F.lds + 16384;
    const size_t R0 = (size_t)b * SEQ + (size_t)j * 128;
    const float lg = log2g_of(h);
#pragma unroll
    for (int i = 0; i < 2; ++i) { const int id = tid + NTHREADS * i, row = id >> 3, ch = id & 7;
        const bf16x8 v = *(const bf16x8*)(F_KR + (R0 + row) * 256 + h * 64 + 8 * ch);
        *(LAS bf16x8*)(kimg + (ch >> 2) * 8192 + row * 64 + (ch & 3) * 16) = v; }
#pragma unroll
    for (int i = 0; i < 4; ++i) { const int id = tid + NTHREADS * i, row = id >> 4, ch = id & 15;
        const u32x4 v = *(const u32x4*)(F_VR + (R0 + row) * 512 + h * 128 + 8 * ch);
        const float sc = __builtin_amdgcn_exp2f((float)(127 - row) * lg);
        u32x4 o; o.x = cvtpk(bflo(v.x) * sc, bfhi(v.x) * sc); o.y = cvtpk(bflo(v.y) * sc, bfhi(v.y) * sc); o.z = cvtpk(bflo(v.z) * sc, bfhi(v.z) * sc); o.w = cvtpk(bflo(v.w) * sc, bfhi(v.w) * sc);
        *(LAS u32x4*)(vimg + (ch >> 2) * 8192 + row * 64 + (ch & 3) * 16) = o; }
    __syncthreads();
    const int db = w >> 2, eb = w & 3;
    f32x16 acc;
#pragma unroll
    for (int r = 0; r < 16; ++r) acc[r] = 0.f;
#pragma unroll
    for (int s = 0; s < 8; ++s)
        acc = __builtin_amdgcn_mfma_f32_32x32x16_bf16(trfrag<false>(kimg + db * 8192, 16 * s, lane), trfrag<false>(vimg + eb * 8192, 16 * s, lane), acc, 0, 0, 0);
    float* kvo = F_KV + ((size_t)((b * 4 + h) * 16 + j)) * 8192;
    const int r32 = lane & 31, hi = lane >> 5;
#pragma unroll
    for (int r = 0; r < 16; ++r) { const int d = 32 * db + (r & 3) + 8 * (r >> 2) + 4 * hi; kvo[d * 128 + 32 * eb + r32] = acc[r]; }
    __syncthreads();
}
__device__ __forceinline__ void ret_out_item(Frame& F, int b, int h, int c) {
    const int tid = F.tid, lane = F.lane, w = F.wave, r32 = lane & 31, hi = lane >> 5;
    LAS unsigned char* vimg = F.lds;
    LAS unsigned char* simg = F.lds + 32768;
    LAS float* stat = (LAS float*)(F.lds + 49152);
    const size_t R0 = (size_t)b * SEQ + (size_t)c * 128;
    const float lg = log2g_of(h), gam = __builtin_amdgcn_exp2f(128.f * lg);
#pragma unroll
    for (int i = 0; i < 4; ++i) { const int id = tid + NTHREADS * i, row = id >> 4, ch = id & 15;
        const bf16x8 v = *(const bf16x8*)(F_VR + (R0 + row) * 512 + h * 128 + 8 * ch);
        *(LAS bf16x8*)(vimg + (ch >> 2) * 8192 + row * 64 + (ch & 3) * 16) = v; }
    {
        const float* kvb = F_KV + (size_t)((b * 4 + h) * 16) * 8192;
        f32x4 S[4];
#pragma unroll
        for (int i = 0; i < 4; ++i) S[i] = (f32x4){0.f, 0.f, 0.f, 0.f};
        for (int j = 0; j < c; ++j) {
#pragma unroll
            for (int i = 0; i < 4; ++i) S[i] = S[i] * gam + *(const f32x4*)(kvb + (size_t)j * 8192 + 4 * (tid + NTHREADS * i));
        }
#pragma unroll
        for (int i = 0; i < 4; ++i) { const int gi = tid + NTHREADS * i, d = gi >> 5, e0 = (gi & 31) * 4;
            u32x2 o; o.x = cvtpk(S[i].x, S[i].y); o.y = cvtpk(S[i].z, S[i].w);
            *(LAS u32x2*)(simg + (e0 >> 5) * 4096 + d * 64 + (e0 & 31) * 2) = o; }
        if (c == 15) {
            float* rp = F_out + OFF_RP + (size_t)(b * 4 + h) * 8192;
#pragma unroll
            for (int i = 0; i < 4; ++i) { const f32x4 fin = S[i] * gam + *(const f32x4*)(kvb + (size_t)15 * 8192 + 4 * (tid + NTHREADS * i)); *(f32x4*)(rp + 4 * (tid + NTHREADS * i)) = fin; }
        }
    }
    __syncthreads();
    const int wq = w >> 1, we = w & 1;
    const int q = 32 * wq + r32;
    bf16x8 qf[4];
#pragma unroll
    for (int s = 0; s < 4; ++s) qf[s] = ld8_bf16(F_QR + (R0 + q) * 256 + h * 64 + 16 * s + 8 * hi);
    f32x16 o[2];
#pragma unroll
    for (int r = 0; r < 16; ++r) { o[0][r] = 0.f; o[1][r] = 0.f; }
#pragma unroll
    for (int eb = 0; eb < 2; ++eb)
#pragma unroll
        for (int s = 0; s < 4; ++s) o[eb] = __builtin_amdgcn_mfma_f32_32x32x16_bf16(trfrag<false>(simg + (2 * we + eb) * 4096, 16 * s, lane), qf[s], o[eb], 0, 0, 0);
    { const float gq = __builtin_amdgcn_exp2f((float)(q + 1) * lg); o[0] = o[0] * gq; o[1] = o[1] * gq; }
    for (int jb = 0; jb <= wq; ++jb) {
        bf16x8 kf[4];
#pragma unroll
        for (int s = 0; s < 4; ++s) kf[s] = ld8_bf16(F_KR + (R0 + 32 * jb + r32) * 256 + h * 64 + 16 * s + 8 * hi);
        f32x16 st;
#pragma unroll
        for (int r = 0; r < 16; ++r) st[r] = 0.f;
#pragma unroll
        for (int s = 0; s < 4; ++s) st = __builtin_amdgcn_mfma_f32_32x32x16_bf16(kf[s], qf[s], st, 0, 0, 0);
#pragma unroll
        for (int r = 0; r < 16; ++r) { const int key = 32 * jb + (r & 3) + 8 * (r >> 2) + 4 * hi, dl = q - key;
            st[r] = dl >= 0 ? st[r] * __builtin_amdgcn_exp2f((float)dl * lg) : 0.f; }
        const bf16x8 pf0 = pack8(st[0], st[1], st[2], st[3], st[4], st[5], st[6], st[7]), pf1 = pack8(st[8], st[9], st[10], st[11], st[12], st[13], st[14], st[15]);
#pragma unroll
        for (int eb = 0; eb < 2; ++eb) {
            o[eb] = __builtin_amdgcn_mfma_f32_32x32x16_bf16(trfrag<true>(vimg + (2 * we + eb) * 8192, 32 * jb, lane), pf0, o[eb], 0, 0, 0);
            o[eb] = __builtin_amdgcn_mfma_f32_32x32x16_bf16(trfrag<true>(vimg + (2 * we + eb) * 8192, 32 * jb + 16, lane), pf1, o[eb], 0, 0, 0);
        }
    }
    float sm = 0.f, sq = 0.f;
#pragma unroll
    for (int r = 0; r < 16; ++r) { sm += o[0][r] + o[1][r]; sq += o[0][r] * o[0][r] + o[1][r] * o[1][r]; }
    sm += __shfl_xor(sm, 32); sq += __shfl_xor(sq, 32);
    if (hi == 0) { stat[(w * 32 + r32) * 2] = sm; stat[(w * 32 + r32) * 2 + 1] = sq; }
    __syncthreads();
    sm += stat[((w ^ 1) * 32 + r32) * 2]; sq += stat[((w ^ 1) * 32 + r32) * 2 + 1];
    const float mean = sm * (1.f / 128.f), var = sq * (1.f / 128.f) - mean * mean, rstd = 1.0f / sqrtf(fmaxf(var, 0.f) + EPS);
    const size_t grow = (R0 + q);
#pragma unroll
    for (int eb = 0; eb < 2; ++eb)
#pragma unroll
        for (int g = 0; g < 4; ++g) {
            const int e = 64 * we + 32 * eb + 8 * g + 4 * hi;
            const f32x4 gn = *(const f32x4*)(F_gain + h * 128 + e);
            const u32x2 sg = *(const u32x2*)(F_GR + grow * 512 + h * 128 + e);
            const float y0 = (o[eb][4 * g] - mean) * rstd * gn.x * bflo(sg.x), y1 = (o[eb][4 * g + 1] - mean) * rstd * gn.y * bfhi(sg.x);
            const float y2 = (o[eb][4 * g + 2] - mean) * rstd * gn.z * bflo(sg.y), y3 = (o[eb][4 * g + 3] - mean) * rstd * gn.w * bfhi(sg.y);
            u32x2 wv; wv.x = cvtpk(y0, y1); wv.y = cvtpk(y2, y3);
            *(u32x2*)(F_MIX + grow * D + 512 + h * 128 + e) = wv;
        }
    __syncthreads();
}
__device__ __forceinline__ void ret_sample_item(Frame& F, int sb, int h) {
    const int tid = F.tid;
    LAS float* q = (LAS float*)F.lds;
    LAS float* k = q + 512;
    LAS float* v = k + 512;
    LAS float* sg = v + 1024;
    LAS float* sc = sg + 1024;
    LAS float* ob = sc + 64;
    const size_t R0 = (size_t)MP + (size_t)sb * DT;
    const float lg = log2g_of(h);
    { const int i = tid >> 6, d = tid & 63; q[tid] = bf2f(F_QR[(R0 + i) * 256 + h * 64 + d]); k[tid] = bf2f(F_KR[(R0 + i) * 256 + h * 64 + d]); }
#pragma unroll
    for (int x = 0; x < 2; ++x) { const int id = tid + NTHREADS * x, i = id >> 7, e = id & 127; v[id] = bf2f(F_VR[(R0 + i) * 512 + h * 128 + e]); sg[id] = bf2f(F_GR[(R0 + i) * 512 + h * 128 + e]); }
    __syncthreads();
    if (tid < 64) { const int i = tid >> 3, j = tid & 7; float s = 0.f;
        for (int d = 0; d < 64; ++d) s += q[i * 64 + d] * k[j * 64 + d];
        sc[tid] = (i >= j) ? s * __builtin_amdgcn_exp2f((float)(i - j) * lg) : 0.f; }
    __syncthreads();
    const float* st0 = F_st + (size_t)(sb * 4 + h) * 8192;
    {
        const int e = tid & 127, ih = tid >> 7;
        float c0 = 0.f, c1 = 0.f;
        for (int d = 0; d < 64; ++d) { const float s0 = st0[d * 128 + e]; c0 += q[ih * 64 + d] * s0; c1 += q[(ih + 4) * 64 + d] * s0; }
        float i0 = 0.f, i1 = 0.f;
#pragma unroll
        for (int j = 0; j < 8; ++j) { i0 += sc[ih * 8 + j] * v[j * 128 + e]; i1 += sc[(ih + 4) * 8 + j] * v[j * 128 + e]; }
        ob[ih * 128 + e] = i0 + c0 * __builtin_amdgcn_exp2f((float)(ih + 1) * lg);
        ob[(ih + 4) * 128 + e] = i1 + c1 * __builtin_amdgcn_exp2f((float)(ih + 5) * lg);
    }
    {
        float* rs = F_out + OFF_RS + (size_t)(sb * 4 + h) * 8192; const float g8 = __builtin_amdgcn_exp2f(8.f * lg);
#pragma unroll
        for (int x = 0; x < 4; ++x) { const int gi = tid + NTHREADS * x, d = gi >> 5, e0 = (gi & 31) * 4;
            f32x4 s = *(const f32x4*)(st0 + d * 128 + e0) * g8;
#pragma unroll
            for (int j = 0; j < 8; ++j) { const float kd = k[j * 64 + d] * __builtin_amdgcn_exp2f((float)(7 - j) * lg); const f32x4 vv = *(const LAS f32x4*)(v + j * 128 + e0); s = s + vv * kd; }
            *(f32x4*)(rs + d * 128 + e0) = s; }
    }
    __syncthreads();
    { const int i = F.wave, lane = F.lane;
        const float a = ob[i * 128 + lane], b2 = ob[i * 128 + 64 + lane];
        const float mean = wave_sum(a + b2) * (1.f / 128.f);
        const float da = a - mean, db = b2 - mean; const float var = wave_sum(da * da + db * db) * (1.f / 128.f), rstd = 1.0f / sqrtf(var + EPS);
        bf16_t* mr = F_MIX + (R0 + i) * D + 512 + h * 128;
        mr[lane] = (bf16_t)f2bf(da * rstd * F_gain[h * 128 + lane] * sg[i * 128 + lane]);
        mr[64 + lane] = (bf16_t)f2bf(db * rstd * F_gain[h * 128 + 64 + lane] * sg[i * 128 + 64 + lane]); }
    __syncthreads();
}


#define XB_TMO      128
#define XB_XCNT(j)  (256  + 64 * (j))
#define XB_XSUB(j)  (1280 + 64 * (j))
#define XB_XGEN(j)  (2304 + 64 * (j))
#define XB_TOP      3328
#define XB_TOPGEN   3392
#define XCD_BAR_WORDS 3456
#define XB_SPIN_CAP (1u << 20)
__device__ __forceinline__ unsigned xb_ld(unsigned* p)              { return __hip_atomic_load(p, __ATOMIC_RELAXED, __HIP_MEMORY_SCOPE_AGENT); }
__device__ __forceinline__ unsigned xb_add(unsigned* p, unsigned v) { return __hip_atomic_fetch_add(p, v, __ATOMIC_RELAXED, __HIP_MEMORY_SCOPE_AGENT); }
__device__ __forceinline__ unsigned xb_xcc_id() { return (unsigned)__builtin_amdgcn_s_getreg((3 << 11) | 20) & 0xFu; }
#define XB_SPIN(cond, bar) do { unsigned _sp = 0; while (cond) { __builtin_amdgcn_s_sleep(1); \
    if ((++_sp & 255u) == 0u) { if (xb_ld(&(bar)[XB_TMO])) break; if (_sp > XB_SPIN_CAP) { atomicAdd(&(bar)[XB_TMO], 1u); break; } } } } while (0)
struct XcdBarrier { unsigned* bar; unsigned x; volatile LAS unsigned* st; };
__device__ __forceinline__ XcdBarrier xcd_barrier_post(unsigned* bar, volatile LAS unsigned* st) {
    XcdBarrier b; b.bar = bar; b.x = xb_xcc_id(); b.st = st;
    if (threadIdx.x == 0) (void)xb_add(&bar[XB_XCNT(b.x)], 1u);
    return b;
}
__device__ __forceinline__ void xcd_barrier_complete(unsigned* bar, unsigned x, unsigned& nloc, unsigned& nx) {
    const unsigned G = gridDim.x * gridDim.y * gridDim.z;
    unsigned sum, cnt, mine, sp = 0u;
    for (;;) {
        sum = 0u; cnt = 0u; mine = 0u;
#pragma unroll
        for (unsigned j = 0; j < 16; ++j) { const unsigned c = xb_ld(&bar[XB_XCNT(j)]); sum += c; cnt += (c > 0u) ? 1u : 0u; mine = (j == x) ? c : mine; }
        if (sum == G) break;
        __builtin_amdgcn_s_sleep(1);
        if ((++sp & 255u) == 0u) { if (xb_ld(&bar[XB_TMO])) break; if (sp > XB_SPIN_CAP) { atomicAdd(&bar[XB_TMO], 1u); break; } }
    }
    nloc = mine > 0u ? mine : 1u; nx = cnt > 0u ? cnt : 1u;
}
__device__ __forceinline__ void xcd_barrier(const XcdBarrier& b) {
    asm volatile("s_waitcnt vmcnt(0)" ::: "memory");
    __syncthreads();
    if (threadIdx.x == 0) {
        unsigned* bar = b.bar;
        __builtin_amdgcn_s_waitcnt(0);
        unsigned nloc = b.st[0], nx = b.st[1];
        if (nloc == 0u) { xcd_barrier_complete(bar, b.x, nloc, nx); b.st[0] = nloc; b.st[1] = nx; }
        const unsigned old = xb_add(&bar[XB_XSUB(b.x)], 1u);
        const unsigned gen = old / nloc;
        if (old + 1u == (gen + 1u) * nloc) {
            __builtin_amdgcn_fence(__ATOMIC_RELEASE, "agent");
            asm volatile("s_waitcnt vmcnt(0)" ::: "memory");
            const unsigned og = xb_add(&bar[XB_TOP], 1u);
            const unsigned tg = og / nx;
            if (og + 1u == (tg + 1u) * nx) xb_add(&bar[XB_TOPGEN], 1u);
            else XB_SPIN(xb_ld(&bar[XB_TOPGEN]) == tg, bar);
            __builtin_amdgcn_fence(__ATOMIC_ACQUIRE, "agent");
            xb_add(&bar[XB_XGEN(b.x)], 1u);
            asm volatile("s_waitcnt vmcnt(0)" ::: "memory");
        } else {
            XB_SPIN(xb_ld(&bar[XB_XGEN(b.x)]) == gen, bar);
            __builtin_amdgcn_fence(__ATOMIC_ACQUIRE, "agent");
            asm volatile("s_waitcnt vmcnt(0)" ::: "memory");
        }
    }
    __syncthreads();
}
constexpr int MISC_OFF = 131072 + 320;

constexpr int N_PHASES = 10;
__global__ void __launch_bounds__(NTHREADS, 2) fwd_kernel(Args args) {
    extern __shared__ __attribute__((aligned(16))) unsigned char lds_raw[];
    Frame F;
    F.lds = (LAS unsigned char*)lds_raw;
    F.tid = threadIdx.x; F.lane = F.tid & 63; F.wave = __builtin_amdgcn_readfirstlane(F.tid >> 6);
    F.G = gridDim.x; { const int bx = blockIdx.x; F.vcu = (F.G % 8 == 0) ? (bx % 8) * (F.G / 8) + bx / 8 : bx; }
    F.a = &args;
    const int lo = args.ph_lo, hi = args.ph_hi;
#ifndef PH_MASK
#define PH_MASK 0x3ff
#endif
#define IN(k) ((((PH_MASK) >> (k)) & 1) && lo <= (k) && (k) < hi)
#if MK_MULTI
#define SEAM(k) do { } while (0)
#elif MK_USE_CG
    cg::grid_group grid = cg::this_grid();
#define SEAM(k) do { if (IN(k) && IN((k) + 1)) grid.sync(); } while (0)
#else
    volatile LAS unsigned* MISC = (volatile LAS unsigned*)(F.lds + MISC_OFF);
    if (F.tid < 32) MISC[F.tid] = 0u;
    __syncthreads();
    XcdBarrier bar = xcd_barrier_post((unsigned*)(args.ws + WS_CTL), MISC + 8);
#define SEAM(k) do { if (IN(k) && IN((k) + 1)) xcd_barrier(bar); } while (0)
#endif
    if (IN(0)) p0_prologue(F);
    SEAM(0);
    if (IN(1)) norm_rows<0>(F);
    SEAM(1);
    if (IN(2)) {
        pg8::Gemm g{F_XN, F_WIN, MP, NIN, D}; pg8::StaticOrder S; S.init(MP, NIN, F.G, (int)blockIdx.x);
        pg8::EpiInProj E{F_QA, F_KA, F_VA, F_QR, F_KR, F_VR, F_GR, F_out, F_TABR, F_TABT};
        pg8::gemm_phase<pg8::EpiInProj, pg8::StaticOrder, true, true>(F.lds, g, S, E);
        pg8::skinny_gemm<4, pg8::EpiInProj>(F.lds, F_XN + (size_t)MP * D, F_WIN, NIN, D, F.vcu, F.G, E);
    }
    SEAM(2);
    if (IN(3)) {
        for (int it = 0; it < 2; ++it) {
            const int bh = F.vcu >> 2, qq = F.vcu & 3, rh = qq & 1, c = (qq >> 1) == 0 ? (it == 0 ? 0 : 3) : (it == 0 ? 1 : 2);
            if (F.vcu < 256) prompt_attn_tile(F, bh >> 3, bh & 7, 8 * rh + F.wave, c, F.lds + F.wave * 4096);
        }
        __syncthreads();
        for (int it = F.vcu; it < 512; it += F.G) ret_kv_item(F, it >> 6, (it >> 4) & 3, it & 15);
    }
    SEAM(3);
    if (IN(4)) {
        for (int it = F.vcu; it < 256; it += F.G) { const int bh = it >> 3, qq = it & 7;
            ret_out_item(F, bh >> 2, bh & 3, qq); ret_out_item(F, bh >> 2, bh & 3, 15 - qq); }
        for (int it = F.vcu; it < 256; it += F.G) sample_attn_item(F, it >> 3, it & 7);
        for (int it = F.vcu; it < 128; it += F.G) ret_sample_item(F, it >> 2, it & 3);
    }
    SEAM(4);
    if (IN(5)) {
        pg8::Gemm g{F_MIX, F_WOUT, MP, D, D}; pg8::StaticOrder S; S.init(MP, D, F.G, (int)blockIdx.x);
        pg8::EpiResid<true> E{F_xp, F_xs, F_X1, F_MOD + 2048, 6144};
        pg8::gemm_phase<pg8::EpiResid<true>, pg8::StaticOrder, true, true>(F.lds, g, S, E);
        pg8::skinny_gemm<1, pg8::EpiResid<true>>(F.lds, F_MIX + (size_t)MP * D, F_WOUT, D, D, F.vcu, F.G, E);
    }
    SEAM(5);
    if (IN(6)) norm_rows<1>(F);
    SEAM(6);
    if (IN(7)) {
        pg8::Gemm g{F_XN, F_W1, MP, FF, D}; pg8::StaticOrder S; S.init(MP, FF, F.G, (int)blockIdx.x);
        pg8::EpiRelu2 E{F_H, FF};
        pg8::gemm_phase<pg8::EpiRelu2, pg8::StaticOrder, true, true>(F.lds, g, S, E);
        pg8::skinny_gemm<4, pg8::EpiRelu2>(F.lds, F_XN + (size_t)MP * D, F_W1, FF, D, F.vcu, F.G, E);
    }
    SEAM(7);
    if (IN(8)) {
        pg8::Gemm g{F_H, F_W2, MP, D, FF}; pg8::StaticOrder S; S.init(MP, D, F.G, (int)blockIdx.x);
        pg8::EpiResid<false> E{nullptr, nullptr, F_X1, F_MOD + 5120, 6144};
        pg8::gemm_phase<pg8::EpiResid<false>, pg8::StaticOrder, true, true>(F.lds, g, S, E);
        pg8::skinny_gemm<1, pg8::EpiResid<false>>(F.lds, F_H + (size_t)MP * FF, F_W2, D, FF, F.vcu, F.G, E);
    }
    SEAM(8);
    if (IN(9)) norm_rows<2>(F);
#undef IN
#undef SEAM
}

extern "C" void kernel_launch(void* const* d_in, const int* in_sizes, int n_in, void* d_out, int out_size, void* d_ws, size_t ws_size, hipStream_t stream) {
    static int grid = 0;
    if (grid == 0) {
        if (n_in != 16 || out_size != OUT_TOTAL || ws_size < WS_END) { fprintf(stderr, "kernel_launch: unexpected problem shape (n_in %d out %d ws %zu)\n", n_in, out_size, ws_size); grid = -1; return; }
        int dev = 0, cus = 0, per_cu = 0;
        if (hipGetDevice(&dev) != hipSuccess || hipDeviceGetAttribute(&cus, hipDeviceAttributeMultiprocessorCount, dev) != hipSuccess) { grid = -1; return; }
        if (hipFuncSetAttribute((const void*)fwd_kernel, hipFuncAttributeMaxDynamicSharedMemorySize, LDS_BYTES) != hipSuccess) { fprintf(stderr, "kernel_launch: hipFuncSetAttribute failed\n"); grid = -1; return; }
        if (hipOccupancyMaxActiveBlocksPerMultiprocessor(&per_cu, (const void*)fwd_kernel, NTHREADS, LDS_BYTES) != hipSuccess || per_cu < 1) { fprintf(stderr, "kernel_launch: occupancy query says %d\n", per_cu); per_cu = 1; }
        (void)hipGetLastError();
        grid = cus;
        if (grid > cus * per_cu) grid = cus * per_cu;
        if (grid != 256) fprintf(stderr, "kernel_launch: note: grid %d\n", grid);
    }
    if (grid < 0) return;
    if (hipMemsetAsync((char*)d_ws + WS_CTL, 0, 16384, stream) != hipSuccess) { fprintf(stderr, "kernel_launch: memset of the barrier words failed\n"); return; }
    Args a{};
    for (int i = 0; i < 16; ++i) a.in[i] = (const float*)d_in[i];
    a.out = (float*)d_out; a.ws = (unsigned char*)d_ws;
#if MK_MULTI
    for (int p = 0; p < N_PHASES; ++p) { a.ph_lo = p; a.ph_hi = p + 1; hipLaunchKernelGGL(fwd_kernel, dim3(grid), dim3(NTHREADS), LDS_BYTES, stream, a); }
#else
    a.ph_lo = 0; a.ph_hi = N_PHASES;
    void* kargs[] = {&a};
    hipError_t e = hipLaunchCooperativeKernel((const void*)fwd_kernel, dim3(grid), dim3(NTHREADS), kargs, LDS_BYTES, stream);
    if (e != hipSuccess) fprintf(stderr, "kernel_launch: cooperative launch failed: %s (grid %d)\n", hipGetErrorString(e), grid);
#endif
}
```

```cpp
#include <hip/hip_runtime.h>
#include <hip/hip_cooperative_groups.h>
#include <cstdio>
#include <cstdint>
namespace cg = cooperative_groups;

#ifndef MK_USE_CG
#define MK_USE_CG 0
#endif
#ifndef MK_MULTI
#define MK_MULTI 0
#endif

#define LAS __attribute__((address_space(3)))
#define GAS __attribute__((address_space(1)))
typedef unsigned short bf16_t;
typedef short bf16x8 __attribute__((ext_vector_type(8)));
typedef short s16x4 __attribute__((ext_vector_type(4)));
typedef float f32x2 __attribute__((ext_vector_type(2)));
typedef float f32x4 __attribute__((ext_vector_type(4)));
typedef float f32x16 __attribute__((ext_vector_type(16)));
typedef unsigned u32x2 __attribute__((ext_vector_type(2)));
typedef unsigned u32x4 __attribute__((ext_vector_type(4)));
typedef __bf16 bf16x2_t __attribute__((ext_vector_type(2)));

constexpr int D = 1024, SEQ = 2048, NB = 8, DBT = 32, DT = 8;
constexpr int MP = NB * SEQ, MS = DBT * DT, M = MP + MS;
constexpr int NIN = 3072, FF = 4096, NMODB = NB + DBT;
constexpr int LCACHE = 2048;
constexpr float EPS = 1e-6f;
constexpr float QSCALE = 0.125f * 1.4426950408889634f;
constexpr size_t OFF_Y = 0, OFF_KP = 17039360, OFF_VP = 25427968, OFF_RP = 33816576, OFF_KS = 34078720, OFF_VS = 34209792, OFF_RS = 34340864;
constexpr int OUT_TOTAL = 35389440;

constexpr size_t MiB = 1u << 20;
constexpr size_t WS_CTL = 0;
constexpr size_t WS_MOD = 1 * MiB;
constexpr size_t WS_MODF = WS_MOD + (size_t)NMODB * 6144 * 4;
constexpr size_t WS_TABR = 3 * MiB;
constexpr size_t WS_TABT = WS_TABR + 2056 * 8 * 8;
constexpr size_t WS_WIN = 4 * MiB;
constexpr size_t WS_WOUT = 10 * MiB;
constexpr size_t WS_W1 = 12 * MiB;
constexpr size_t WS_W2 = 20 * MiB;
constexpr size_t WS_XN = 28 * MiB;
constexpr size_t WS_QA = 61 * MiB;
constexpr size_t WS_KA = 78 * MiB;
constexpr size_t WS_VA = 95 * MiB;
constexpr size_t WS_QR = 112 * MiB;
constexpr size_t WS_KR = 121 * MiB;
constexpr size_t WS_VR = 130 * MiB;
constexpr size_t WS_GR = 147 * MiB;
constexpr size_t WS_MIX = 164 * MiB;
constexpr size_t WS_KV = 197 * MiB;
constexpr size_t WS_X1 = 214 * MiB;
constexpr size_t WS_H = 280 * MiB;
constexpr size_t WS_RSS = 411 * MiB;
constexpr size_t WS_RSSS = 412 * MiB;
constexpr size_t WS_SHB = WS_RSSS + 65536;
constexpr size_t WS_SHW = 413 * MiB;
constexpr size_t WS_END = 414 * MiB;

constexpr int NWAVES = 8, NTHREADS = 512;
constexpr int LDS_BYTES = 147456;

__device__ const double INVF[40] = {
    1.0, 0.19392274474868576, 0.03760603093086393, 0.007292664737217109, 0.001414213562373095, 0.0002742481756762073, 5.318295896944988e-05, 1.031338537721246e-05,
    1.0, 0.7429639507594948, 0.551995432128157, 0.41011270705513014, 0.30469895709035083, 0.22638034095214482, 0.16819243248808696, 0.1249609141291987,
    0.09284145445194744, 0.06897785379387654, 0.05124805876960934, 0.038075460212223716, 0.028288694346259694, 0.021017480113324882, 0.015615230060004972,
    0.011601553017399714, 0.008619535664753033, 0.006404004271197283, 0.004757944314009409, 0.0035349811050301057, 0.0026263635276533325, 0.0019512934226359642,
    0.0014497406703726315, 0.001077105056036769, 0.0008002502278161052, 0.0005945570708544394, 0.00044173447031400687, 0.0003281927872511474,
    0.0002438354098268829, 0.00018116091942004152, 0.00013459603241553644, 0.0001};
__device__ __forceinline__ float log2g_of(int h) { return h == 0 ? -0.04580368961312479f : h == 1 ? -0.02272007650008353f : h == 2 ? -0.011315313227834146f : -0.005646563141142063f; }

__device__ __forceinline__ unsigned cvtpk(float lo, float hi) { f32x2 v = {lo, hi}; bf16x2_t b = __builtin_convertvector(v, bf16x2_t); return __builtin_bit_cast(unsigned, b); }
__device__ __forceinline__ float bf2f(unsigned short u) { return __uint_as_float((unsigned)u << 16); }
__device__ __forceinline__ float bflo(unsigned u) { return __uint_as_float(u << 16); }
__device__ __forceinline__ float bfhi(unsigned u) { return __uint_as_float(u & 0xffff0000u); }
__device__ __forceinline__ int row_bidx(int r) { return r < MP ? (r >> 11) : NB + ((r - MP) >> 3); }
__device__ __forceinline__ int row_tab(int r) { return r < MP ? (r & 2047) : 2048 + ((r - MP) & 7); }
__device__ __forceinline__ float wave_sum(float v) {
#pragma unroll
    for (int o = 1; o < 64; o <<= 1) v += __shfl_xor(v, o);
    return v;
}

namespace pg8 {
#define PG8_LAS __attribute__((address_space(3)))
constexpr int BM = 256, BK = 64, HALF = 128, HTB = HALF * BK * 2, STAGE_BYTES = 8 * HTB, NXCD = 8, WGM = 8;
__host__ __device__ __forceinline__ int lds_byte(int r, int c) { const int st = (r >> 4) * 2 + (c >> 5), rr = r & 15, cc = c & 31, ob = rr * 64 + cc * 2; return st * 1024 + (ob ^ (((ob >> 9) & 1) << 5)); }
__host__ __device__ __forceinline__ void stage_rc(int b, int& R, int& C) { const int st = b / 1024, sb = b % 1024, swz = sb ^ (((sb >> 9) & 1) << 5); R = (st >> 1) * 16 + swz / 64; C = (st & 1) * 32 + (swz % 64) / 2; }
__host__ __device__ __forceinline__ int perm32(int rho) { const int n = rho >> 4, i = rho & 15; return 8 * (i >> 2) + 4 * n + (i & 3); }
struct Unit { int pm, pn; };
struct Gemm { const bf16_t* A; const bf16_t* Bt; int M, N, K; };
struct StaticOrder {
    int nM, nN, nwg, G, c;
    __host__ __device__ void init(int M_, int N_, int G_, int c_) { nM = M_ / BM; nN = N_ / BM; nwg = nM * nN; G = G_; c = c_; }
    __host__ __device__ bool next(int i, Unit& u) const {
        const long L = (long)i * G + c; if (L >= nwg) return false;
        int wgid = (int)L; { const int q = nwg / NXCD, r = nwg % NXCD, xcd = wgid % NXCD, off = wgid / NXCD; wgid = (xcd < r ? xcd * (q + 1) : r * (q + 1) + (xcd - r) * q) + off; }
        const int nig = WGM * nN, gid = wgid / nig, fm = gid * WGM, gsz = (nM - fm) < WGM ? (nM - fm) : WGM;
        u.pm = fm + ((wgid % nig) % gsz); u.pn = (wgid % nig) / gsz; return true;
    }
    __device__ __forceinline__ void a_ready(const Unit&) const {}
    __device__ __forceinline__ void done(const Unit&) const {}
};

template <class Epi, class Sched, bool ALIGN_EPI = false, bool SP2 = false>
__device__ __forceinline__ void gemm_phase(PG8_LAS unsigned char* lds, const Gemm g, const Sched& S, const Epi& E) {
    const int tid = threadIdx.x, wid = __builtin_amdgcn_readfirstlane(tid >> 6), lane = tid & 63, wr = wid >> 2, wc = wid & 3, fr = lane & 15, fq = lane >> 4;
    const int K = g.K, nt = K / BK;
    unsigned voffA[2], voffB[2];
#pragma unroll
    for (int i = 0; i < 2; ++i) { int R, C; stage_rc(tid * 16 + i * 8192, R, C); const int Rb = Epi::PERM ? ((R & ~31) + perm32(R & 31)) : R;
        voffA[i] = (unsigned)(R * K + C) * 2u; voffB[i] = (unsigned)(Rb * K + C) * 2u; }
    const size_t kstep = (size_t)(BK * 2);
    const size_t hstep = (size_t)HALF * K * 2;
    const size_t tstep = 2 * hstep;
    const unsigned ldsw = (unsigned)wid * 1024u;
    const int aoff = lds_byte(wr * 64 + fr, fq * 8), boff = lds_byte(wc * 32 + fr, fq * 8);
#define PG8_SA(b, h) (((b) * 2 + (h)) * HTB)
#define PG8_SB(b, h) ((4 + (b) * 2 + (h)) * HTB)
#define PG8_STAGE(bufoff, gbase, voff) do { _Pragma("unroll") for (int _i = 0; _i < 2; ++_i) \
        __builtin_amdgcn_global_load_lds((const unsigned*)((const char*)(gbase) + (voff)[_i]), (PG8_LAS unsigned*)(lds + (bufoff) + ldsw + _i * 8192), 16, 0, 0); } while (0)
#define PG8_LDA(dst, b, h) do { _Pragma("unroll") for (int m = 0; m < 4; ++m) _Pragma("unroll") for (int k = 0; k < 2; ++k) dst[m][k] = *(const PG8_LAS bf16x8*)(lds + PG8_SA(b, h) + aoff + m * 2048 + k * 1024); } while (0)
#define PG8_LDB(dst, b, h) do { _Pragma("unroll") for (int n = 0; n < 2; ++n) _Pragma("unroll") for (int k = 0; k < 2; ++k) dst[n][k] = *(const PG8_LAS bf16x8*)(lds + PG8_SB(b, h) + boff + n * 2048 + k * 1024); } while (0)
#define PG8_MMA(ai, bj, At, Bt) do { __builtin_amdgcn_s_setprio(1); _Pragma("unroll") for (int m = 0; m < 4; ++m) _Pragma("unroll") for (int n = 0; n < 2; ++n) _Pragma("unroll") for (int k = 0; k < 2; ++k) \
        acc[ai][bj][m][n] = __builtin_amdgcn_mfma_f32_16x16x32_bf16(Bt[n][k], At[m][k], acc[ai][bj][m][n], 0, 0, 0); __builtin_amdgcn_s_setprio(0); } while (0)
#define PG8_WAIT_V(n) asm volatile("s_waitcnt vmcnt(" #n ")" ::: "memory")
#define PG8_WAIT_L(n) asm volatile("s_waitcnt lgkmcnt(" #n ")" ::: "memory")
#define PG8_BAR __builtin_amdgcn_s_barrier()
#define PG8_SCHED __builtin_amdgcn_sched_barrier(0)
    Unit cur, nxt; int ui = 0;
    if (!S.next(0, cur)) return;
    f32x4 acc[2][2][4][2];
#pragma unroll
    for (int a = 0; a < 2; ++a)
#pragma unroll
        for (int b = 0; b < 2; ++b)
#pragma unroll
            for (int m = 0; m < 4; ++m)
#pragma unroll
                for (int n = 0; n < 2; ++n) acc[a][b][m][n] = (f32x4){0.f, 0.f, 0.f, 0.f};
    bf16x8 At[4][2], B0[2][2], B1[2][2];
    const char* cA = (const char*)g.A + (size_t)cur.pm * tstep; const char* cB = (const char*)g.Bt + (size_t)cur.pn * tstep;
    S.a_ready(cur);
    if constexpr (SP2) {
        PG8_STAGE(PG8_SB(0, 0), cB, voffB); PG8_STAGE(PG8_SB(0, 1), cB + hstep, voffB); PG8_STAGE(PG8_SA(0, 0), cA, voffA); PG8_STAGE(PG8_SA(0, 1), cA + hstep, voffA);
        if (wr == 1) PG8_BAR;
        PG8_WAIT_V(2); PG8_BAR;
        PG8_STAGE(PG8_SB(1, 0), cB + kstep, voffB); PG8_STAGE(PG8_SA(1, 0), cA + kstep, voffA); PG8_STAGE(PG8_SB(1, 1), cB + hstep + kstep, voffB);
        PG8_WAIT_V(6); PG8_BAR;
    } else {
        PG8_STAGE(PG8_SB(0, 0), cB, voffB); PG8_STAGE(PG8_SA(0, 0), cA, voffA); PG8_STAGE(PG8_SB(0, 1), cB + hstep, voffB); PG8_STAGE(PG8_SA(0, 1), cA + hstep, voffA);
        if (wr == 1) PG8_BAR;
        PG8_WAIT_V(4); PG8_BAR;
        PG8_STAGE(PG8_SB(1, 0), cB + kstep, voffB); PG8_STAGE(PG8_SA(1, 0), cA + kstep, voffA); PG8_STAGE(PG8_SB(1, 1), cB + hstep + kstep, voffB);
        PG8_WAIT_V(6); PG8_BAR;
    }
    for (;;) {
        const bool has_next = S.next(ui + 1, nxt);
        const char* nA = has_next ? (const char*)g.A + (size_t)nxt.pm * tstep : cA; const char* nB = has_next ? (const char*)g.Bt + (size_t)nxt.pn * tstep : cB;
        for (int t = 0; t < nt; t += 2) {
            const bool last = (t == nt - 2);
            const char* a1 = cA + (size_t)(t + 1) * kstep;
            const char* a2 = last ? nA : cA + (size_t)(t + 2) * kstep; const char* b2 = last ? nB : cB + (size_t)(t + 2) * kstep;
            const char* a3 = a2 + kstep; const char* b3 = b2 + kstep;
            if (last && has_next) S.a_ready(nxt);
            if constexpr (SP2) {
            PG8_LDB(B0, 0, 0); PG8_LDB(B1, 0, 1); PG8_SCHED; PG8_LDA(At, 0, 0); PG8_STAGE(PG8_SA(1, 1), a1 + hstep, voffA);
            PG8_WAIT_V(8); PG8_WAIT_L(0); PG8_BAR; PG8_MMA(0, 0, At, B0); PG8_MMA(0, 1, At, B1); PG8_BAR; PG8_SCHED;
            PG8_LDA(At, 0, 1); PG8_STAGE(PG8_SB(0, 0), b2, voffB); PG8_STAGE(PG8_SB(0, 1), b2 + hstep, voffB); PG8_STAGE(PG8_SA(0, 0), a2, voffA);
            PG8_WAIT_V(8); PG8_WAIT_L(0); PG8_BAR; PG8_MMA(1, 0, At, B0); PG8_MMA(1, 1, At, B1); PG8_BAR; PG8_SCHED;
            PG8_LDB(B0, 1, 0); PG8_LDB(B1, 1, 1); PG8_SCHED; PG8_LDA(At, 1, 0); PG8_STAGE(PG8_SA(0, 1), a2 + hstep, voffA);
            PG8_WAIT_V(8); PG8_WAIT_L(0); PG8_BAR; PG8_MMA(0, 0, At, B0); PG8_MMA(0, 1, At, B1); PG8_BAR; PG8_SCHED;
            PG8_LDA(At, 1, 1); PG8_STAGE(PG8_SB(1, 0), b3, voffB); PG8_STAGE(PG8_SB(1, 1), b3 + hstep, voffB); PG8_STAGE(PG8_SA(1, 0), a3, voffA);
            PG8_WAIT_V(8); PG8_WAIT_L(0); PG8_BAR; PG8_MMA(1, 0, At, B0); PG8_MMA(1, 1, At, B1); PG8_BAR; PG8_SCHED;
            } else {
            PG8_LDB(B0, 0, 0); PG8_SCHED; PG8_LDA(At, 0, 0); PG8_STAGE(PG8_SA(1, 1), a1 + hstep, voffA);
            PG8_WAIT_L(8); PG8_BAR; PG8_WAIT_L(0); PG8_MMA(0, 0, At, B0); PG8_BAR; PG8_SCHED;
            PG8_LDB(B1, 0, 1); PG8_STAGE(PG8_SB(0, 0), b2, voffB);
            PG8_BAR; PG8_WAIT_L(0); PG8_MMA(0, 1, At, B1); PG8_BAR;
            PG8_LDA(At, 0, 1); PG8_STAGE(PG8_SA(0, 0), a2, voffA);
            PG8_BAR; PG8_WAIT_L(0); PG8_MMA(1, 0, At, B0); PG8_BAR; PG8_SCHED;
            PG8_STAGE(PG8_SB(0, 1), b2 + hstep, voffB);
            PG8_WAIT_V(6); PG8_BAR; PG8_MMA(1, 1, At, B1); PG8_BAR;
            PG8_LDB(B0, 1, 0); PG8_SCHED; PG8_LDA(At, 1, 0); PG8_STAGE(PG8_SA(0, 1), a2 + hstep, voffA);
            PG8_WAIT_L(8); PG8_BAR; PG8_WAIT_L(0); PG8_MMA(0, 0, At, B0); PG8_BAR; PG8_SCHED;
            PG8_LDB(B1, 1, 1); PG8_STAGE(PG8_SB(1, 0), b3, voffB);
            PG8_BAR; PG8_WAIT_L(0); PG8_MMA(0, 1, At, B1); PG8_BAR;
            PG8_LDA(At, 1, 1); PG8_STAGE(PG8_SA(1, 0), a3, voffA);
            PG8_BAR; PG8_WAIT_L(0); PG8_MMA(1, 0, At, B0); PG8_BAR; PG8_SCHED;
            PG8_STAGE(PG8_SB(1, 1), b3 + hstep, voffB);
            PG8_WAIT_V(6); PG8_BAR; PG8_MMA(1, 1, At, B1); PG8_BAR;
            }
        }
        if constexpr (ALIGN_EPI) { if (wr == 0) PG8_BAR; }
        E(acc, cur, wr, wc, fr, fq); S.done(cur);
        if (!has_next) break;
#pragma unroll
        for (int a = 0; a < 2; ++a)
#pragma unroll
            for (int b = 0; b < 2; ++b)
#pragma unroll
                for (int m = 0; m < 4; ++m)
#pragma unroll
                    for (int n = 0; n < 2; ++n) acc[a][b][m][n] = (f32x4){0.f, 0.f, 0.f, 0.f};
        cur = nxt; cA = nA; cB = nB; ++ui;
        if constexpr (ALIGN_EPI) { if (wr == 1) PG8_BAR; }
    }
    PG8_WAIT_V(0);
    if constexpr (!ALIGN_EPI) { if (wr == 0) PG8_BAR; }
    PG8_BAR;
#undef PG8_SA
#undef PG8_SB
#undef PG8_STAGE
#undef PG8_LDA
#undef PG8_LDB
#undef PG8_MMA
#undef PG8_WAIT_V
#undef PG8_WAIT_L
#undef PG8_BAR
#undef PG8_SCHED
}


struct EpiInProj {
    static constexpr bool PERM = true;
    bf16_t *QA, *KA, *VA, *QR, *KR, *VR, *GR; float* out; const f32x2* tabr; const f32x2* tabt;
    template <int TY> __device__ __forceinline__ f32x4 xform(int tp, int col, f32x4 v, bool rope16, int pxor, bool act, bool first, int jb) const {
        if constexpr (TY == 0 || TY == 1) {
            if (rope16) {
                const f32x2* tb = tabr + tp * 8 + jb;
#pragma unroll
                for (int e = 0; e < 4; ++e) { const float pv = __shfl_xor(v[e], pxor); const f32x2 cs = tb[e];
                    const float rot = first ? (v[e] * cs.x - pv * cs.y) : (v[e] * cs.x + pv * cs.y); v[e] = act ? rot : v[e]; }
            }
            if constexpr (TY == 0) v = v * QSCALE;
        }
        if constexpr (TY == 3 || TY == 4) {
            const f32x2* tb = tabt + tp * 32 + ((col & 63) >> 1);
            const f32x2 c0 = tb[0], c1 = tb[1];
            const float a0 = v[0] * c0.x - v[1] * c0.y, a1 = v[1] * c0.x + v[0] * c0.y, a2 = v[2] * c1.x - v[3] * c1.y, a3 = v[3] * c1.x + v[2] * c1.y;
            v = (f32x4){a0, a1, a2, a3};
            if constexpr (TY == 4) v = v * 0.125f;
        }
        if constexpr (TY == 6) {
#pragma unroll
            for (int e = 0; e < 4; ++e) v[e] = v[e] / (1.0f + __builtin_amdgcn_exp2f(-1.4426950408889634f * v[e]));
        }
        return v;
    }
    template <int TY> __device__ __forceinline__ bf16_t* dstp(int r, int col) const {
        if constexpr (TY == 0) return QA + (size_t)r * 512 + col; else if constexpr (TY == 1) return KA + (size_t)r * 512 + col; else if constexpr (TY == 2) return VA + (size_t)r * 512 + col;
        else if constexpr (TY == 3) return QR + (size_t)r * 256 + col; else if constexpr (TY == 4) return KR + (size_t)r * 256 + col; else if constexpr (TY == 5) return VR + (size_t)r * 512 + col; else return GR + (size_t)r * 512 + col;
    }
    template <int TY> __device__ __forceinline__ float* outp(int r, int col) const {
        return out + (TY == 1 ? (r < MP ? OFF_KP : OFF_KS) : (r < MP ? OFF_VP : OFF_VS)) + (size_t)(r < MP ? r : r - MP) * 512 + col;
    }
    template <int TY> __device__ __forceinline__ void run(const f32x4 (&acc)[2][2][4][2], const Unit& u, int wr, int wc, int fr, int fq) const {
        const int cb = (TY <= 2 || TY >= 5) ? (u.pn & 1) * 256 : 0;
        const bool rope16 = (wc & 1) == 0;
#pragma unroll
        for (int ai = 0; ai < 2; ++ai)
#pragma unroll
            for (int m = 0; m < 4; ++m) {
                const int r = u.pm * BM + ai * HALF + wr * 64 + m * 16 + fr; const int tp = row_tab(r);
#pragma unroll
                for (int bj = 0; bj < 2; ++bj) {
                    const int col = cb + bj * HALF + wc * 32 + fq * 8;
                    const f32x4 v0 = xform<TY>(tp, col, acc[ai][bj][m][0], rope16, 16, fq < 2, fq == 0, 0);
                    const f32x4 v1 = xform<TY>(tp, col + 4, acc[ai][bj][m][1], rope16, 16, fq < 2, fq == 0, 4);
                    if constexpr (TY == 1 || TY == 2) { float* o = outp<TY>(r, col); *(f32x4*)o = v0; *(f32x4*)(o + 4) = v1; }
                    u32x4 w; w.x = cvtpk(v0[0], v0[1]); w.y = cvtpk(v0[2], v0[3]); w.z = cvtpk(v1[0], v1[1]); w.w = cvtpk(v1[2], v1[3]);
                    *(u32x4*)dstp<TY>(r, col) = w;
                }
            }
    }
    __device__ __forceinline__ void operator()(const f32x4 (&acc)[2][2][4][2], const Unit& u, int wr, int wc, int fr, int fq) const {
        const int pn = u.pn;
        if (pn < 2) run<0>(acc, u, wr, wc, fr, fq);
        else if (pn < 4) run<1>(acc, u, wr, wc, fr, fq);
        else if (pn < 6) run<2>(acc, u, wr, wc, fr, fq);
        else if (pn == 6) run<3>(acc, u, wr, wc, fr, fq);
        else if (pn == 7) run<4>(acc, u, wr, wc, fr, fq);
        else if (pn < 10) run<5>(acc, u, wr, wc, fr, fq);
        else run<6>(acc, u, wr, wc, fr, fq);
    }
    template <int TY> __device__ __forceinline__ void elem_t(int r, int col, f32x4 v, bool rope16, int fq) const {
        v = xform<TY>(row_tab(r), col, v, rope16, 32, true, fq < 2, (fq & 1) * 4);
        if constexpr (TY == 1 || TY == 2) *(f32x4*)outp<TY>(r, col) = v;
        u32x2 w; w.x = cvtpk(v[0], v[1]); w.y = cvtpk(v[2], v[3]);
        *(u32x2*)dstp<TY>(r, col) = w;
    }
    __device__ __forceinline__ void elem(int r, int gc, f32x4 v, int fq) const {
        const int pn = __builtin_amdgcn_readfirstlane(gc >> 8); const bool rope16 = __builtin_amdgcn_readfirstlane(gc & 48) == 0;
        if (pn < 2) elem_t<0>(r, gc, v, rope16, fq);
        else if (pn < 4) elem_t<1>(r, gc - 512, v, rope16, fq);
        else if (pn < 6) elem_t<2>(r, gc - 1024, v, false, fq);
        else if (pn == 6) elem_t<3>(r, gc - 1536, v, false, fq);
        else if (pn == 7) elem_t<4>(r, gc - 1792, v, false, fq);
        else if (pn < 10) elem_t<5>(r, gc - 2048, v, false, fq);
        else elem_t<6>(r, gc - 2560, v, false, fq);
    }
};
template <bool FROM_X> struct EpiResid {
    static constexpr bool PERM = true;
    const float* xp; const float* xs; float* dst; const float* gate; int gld;
    __device__ __forceinline__ void elem(int r, int col, f32x4 v, int) const {
        const float* g = gate + (size_t)row_bidx(r) * gld;
        const float* base = FROM_X ? (r < MP ? xp + (size_t)r * D : xs + (size_t)(r - MP) * D) : dst + (size_t)r * D;
        const f32x4 b = *(const f32x4*)(base + col), gg = *(const f32x4*)(g + col);
        *(f32x4*)(dst + (size_t)r * D + col) = b + gg * v;
    }
    __device__ __forceinline__ void operator()(const f32x4 (&acc)[2][2][4][2], const Unit& u, int wr, int wc, int fr, int fq) const {
#pragma unroll
        for (int ai = 0; ai < 2; ++ai)
#pragma unroll
            for (int m = 0; m < 4; ++m) {
                const int r = u.pm * BM + ai * HALF + wr * 64 + m * 16 + fr;
#pragma unroll
                for (int bj = 0; bj < 2; ++bj) { const int col = u.pn * BM + bj * HALF + wc * 32 + fq * 8; elem(r, col, acc[ai][bj][m][0], fq); elem(r, col + 4, acc[ai][bj][m][1], fq); }
            }
    }
};
struct EpiOutProj {
    static constexpr bool PERM = true;
    const float* xp; const float* xs; float* X1; bf16_t* XN; const float* mod; float* rss; float* rsss;
    __device__ __forceinline__ f32x4 x1of(const float* base, const float* mrow, int col, f32x4 v, f32x4& a2) const {
        const f32x4 b = *(const f32x4*)(base + col), gg = *(const f32x4*)(mrow + 2048 + col), sc = *(const f32x4*)(mrow + 4096 + col);
        const f32x4 x1 = b + gg * v; a2 = x1 * (sc + 1.0f); return x1;
    }
    __device__ __forceinline__ void elem(int r, int col, f32x4 v, int fq) const {
        const float* mrow = mod + (size_t)row_bidx(r) * 6144; const float* base = r < MP ? xp + (size_t)r * D : xs + (size_t)(r - MP) * D;
        f32x4 a2; const f32x4 x1 = x1of(base, mrow, col, v, a2);
        *(f32x4*)(X1 + (size_t)r * D + col) = x1;
        u32x2 w; w.x = cvtpk(a2.x, a2.y); w.y = cvtpk(a2.z, a2.w); *(u32x2*)(XN + (size_t)r * D + col) = w;
        float ss = (x1.x * x1.x + x1.y * x1.y) + (x1.z * x1.z + x1.w * x1.w);
        ss += __shfl_xor(ss, 16); ss += __shfl_xor(ss, 32);
        if (fq == 0) atomicAdd(rss + r, ss);
    }
    __device__ __forceinline__ void operator()(const f32x4 (&acc)[2][2][4][2], const Unit& u, int wr, int wc, int fr, int fq) const {
        const float* mrow = mod + (size_t)(u.pm >> 3) * 6144;
#pragma unroll
        for (int ai = 0; ai < 2; ++ai)
#pragma unroll
            for (int m = 0; m < 4; ++m) {
                const int r = u.pm * BM + ai * HALF + wr * 64 + m * 16 + fr; const float* base = xp + (size_t)r * D;
                float ss = 0.f;
#pragma unroll
                for (int bj = 0; bj < 2; ++bj) {
                    const int col = u.pn * BM + bj * HALF + wc * 32 + fq * 8;
                    f32x4 a20, a21; const f32x4 x10 = x1of(base, mrow, col, acc[ai][bj][m][0], a20), x11 = x1of(base, mrow, col + 4, acc[ai][bj][m][1], a21);
                    *(f32x4*)(X1 + (size_t)r * D + col) = x10; *(f32x4*)(X1 + (size_t)r * D + col + 4) = x11;
                    u32x4 w; w.x = cvtpk(a20.x, a20.y); w.y = cvtpk(a20.z, a20.w); w.z = cvtpk(a21.x, a21.y); w.w = cvtpk(a21.z, a21.w);
                    *(u32x4*)(XN + (size_t)r * D + col) = w;
                    ss += ((x10.x * x10.x + x10.y * x10.y) + (x10.z * x10.z + x10.w * x10.w)) + ((x11.x * x11.x + x11.y * x11.y) + (x11.z * x11.z + x11.w * x11.w));
                }
                ss += __shfl_xor(ss, 16); ss += __shfl_xor(ss, 32);
                if (fq == 0) atomicAdd(rss + r, ss);
            }
    }
};
struct EpiStoreF32 {
    static constexpr bool PERM = false;
    float* O; int ldc;
    __device__ __forceinline__ void elem(int r, int col, f32x4 v, int) const { *(f32x4*)(O + (size_t)r * ldc + col) = v; }
};
struct EpiRelu2 {
    static constexpr bool PERM = true;
    bf16_t* O; int ldc; const float* rss; const float* rsss; const float* shw;
    __device__ __forceinline__ void elem(int r, int col, f32x4 v, int) const {
        const float rstd = 1.0f / sqrtf(rss[r] * (1.f / D) + EPS);
        const f32x4 sh = *(const f32x4*)(shw + (size_t)row_bidx(r) * FF + col);
#pragma unroll
        for (int e = 0; e < 4; ++e) { const float a = fmaxf(v[e] * rstd + sh[e], 0.f); v[e] = a * a; }
        u32x2 w; w.x = cvtpk(v[0], v[1]); w.y = cvtpk(v[2], v[3]);
        *(u32x2*)(O + (size_t)r * ldc + col) = w;
    }
    __device__ __forceinline__ void operator()(const f32x4 (&acc)[2][2][4][2], const Unit& u, int wr, int wc, int fr, int fq) const {
        const int row0 = u.pm * BM + wr * 64 + fr, col0 = u.pn * BM + wc * 32 + 8 * fq;
        const float* shp = shw + (size_t)(u.pm >> 3) * FF + col0;
        const f32x4 s00 = *(const f32x4*)(shp), s01 = *(const f32x4*)(shp + 4), s10 = *(const f32x4*)(shp + HALF), s11 = *(const f32x4*)(shp + HALF + 4);
#pragma unroll
        for (int ai = 0; ai < 2; ++ai)
#pragma unroll
            for (int m = 0; m < 4; ++m) { const int r = row0 + ai * HALF + m * 16; bf16_t* rowp = O + (size_t)r * ldc + col0;
                const float rstd = 1.0f / sqrtf(rss[r] * (1.f / D) + EPS);
#pragma unroll
                for (int bj = 0; bj < 2; ++bj) { f32x4 v0 = acc[ai][bj][m][0] * rstd + (bj == 0 ? s00 : s10), v1 = acc[ai][bj][m][1] * rstd + (bj == 0 ? s01 : s11);
#pragma unroll
                    for (int e = 0; e < 4; ++e) { const float a = fmaxf(v0[e], 0.f), b = fmaxf(v1[e], 0.f); v0[e] = a * a; v1[e] = b * b; }
                    u32x4 w; w.x = cvtpk(v0[0], v0[1]); w.y = cvtpk(v0[2], v0[3]); w.z = cvtpk(v1[0], v1[1]); w.w = cvtpk(v1[2], v1[3]);
                    *(u32x4*)(rowp + bj * HALF) = w; } }
    }
};

template <int NT, class Epi>
__device__ __forceinline__ void skinny_unit(PG8_LAS unsigned char* lds, const bf16_t* A, const bf16_t* Bt, int K, int mblk, int nblk, int rowbase, const Epi& E) {
    const int tid = threadIdx.x, w = __builtin_amdgcn_readfirstlane(tid >> 6), lane = tid & 63, fr = lane & 15, fq = lane >> 4;
    const int kw = K >> 3;
    f32x4 acc[4][NT];
#pragma unroll
    for (int mt = 0; mt < 4; ++mt)
#pragma unroll
        for (int nt = 0; nt < NT; ++nt) acc[mt][nt] = (f32x4){0.f, 0.f, 0.f, 0.f};
    const bf16_t* ap = A + (size_t)(mblk * 64 + fr) * K + w * kw + 8 * fq;
    const bf16_t* bp = Bt + (size_t)(nblk * 16 * NT + fr) * K + w * kw + 8 * fq;
#pragma unroll 2
    for (int ks = 0; ks < kw; ks += 32) {
        bf16x8 af[4], bfr[NT];
#pragma unroll
        for (int mt = 0; mt < 4; ++mt) af[mt] = *(const bf16x8*)(ap + (size_t)mt * 16 * K + ks);
#pragma unroll
        for (int nt = 0; nt < NT; ++nt) bfr[nt] = *(const bf16x8*)(bp + (size_t)nt * 16 * K + ks);
#pragma unroll
        for (int mt = 0; mt < 4; ++mt)
#pragma unroll
            for (int nt = 0; nt < NT; ++nt) acc[mt][nt] = __builtin_amdgcn_mfma_f32_16x16x32_bf16(bfr[nt], af[mt], acc[mt][nt], 0, 0, 0);
    }
    PG8_LAS f32x4* red = (PG8_LAS f32x4*)lds;
#pragma unroll
    for (int mt = 0; mt < 4; ++mt)
#pragma unroll
        for (int nt = 0; nt < NT; ++nt) red[((w * 4 + mt) * NT + nt) * 64 + lane] = acc[mt][nt];
    __syncthreads();
    for (int t = w; t < 4 * NT; t += 8) { const int mt = t / NT, nt = t % NT;
        f32x4 v = red[(mt * NT + nt) * 64 + lane];
#pragma unroll
        for (int ww = 1; ww < 8; ++ww) v = v + red[((ww * 4 + mt) * NT + nt) * 64 + lane];
        E.elem(rowbase + mblk * 64 + mt * 16 + fr, (nblk * NT + nt) * 16 + 4 * fq, v, fq);
    }
    __syncthreads();
}
template <int NT, class Epi>
__device__ __forceinline__ void skinny_gemm(PG8_LAS unsigned char* lds, const bf16_t* Asample, const bf16_t* Bt, int N, int K, int first, int G, const Epi& E) {
    const int ncol = N / (16 * NT), nunits = 4 * ncol;
    for (int u = first; u < nunits; u += G) skinny_unit<NT, Epi>(lds, Asample, Bt, K, u / ncol, u % ncol, MP, E);
}
}

struct Args { const float* in[16]; float* out; unsigned char* ws; int ph_lo, ph_hi; };
struct Frame {
    LAS unsigned char* lds;
    int tid, lane, wave, vcu, G;
    const Args* a;
#define FIN(i) ((const float*)F.a->in[i])
#define FWS(T, off) ((T*)(F.a->ws + (off)))
};
#define F_xp FIN(0)
#define F_xs FIN(1)
#define F_cp FIN(2)
#define F_cs FIN(3)
#define F_ck FIN(4)
#define F_cv FIN(5)
#define F_st FIN(6)
#define F_w_ada FIN(7)
#define F_b_ada FIN(8)
#define F_w_in FIN(9)
#define F_gain FIN(10)
#define F_w_out FIN(11)
#define F_w_ff1 FIN(12)
#define F_w_ff2 FIN(13)
#define F_w_adaf FIN(14)
#define F_b_adaf FIN(15)
#define F_out (F.a->out)
#define F_MOD FWS(float, WS_MOD)
#define F_MODF FWS(float, WS_MODF)
#define F_TABR FWS(f32x2, WS_TABR)
#define F_TABT FWS(f32x2, WS_TABT)
#define F_WIN FWS(bf16_t, WS_WIN)
#define F_WOUT FWS(bf16_t, WS_WOUT)
#define F_W1 FWS(bf16_t, WS_W1)
#define F_W2 FWS(bf16_t, WS_W2)
#define F_XN FWS(bf16_t, WS_XN)
#define F_QA FWS(bf16_t, WS_QA)
#define F_KA FWS(bf16_t, WS_KA)
#define F_VA FWS(bf16_t, WS_VA)
#define F_QR FWS(bf16_t, WS_QR)
#define F_KR FWS(bf16_t, WS_KR)
#define F_VR FWS(bf16_t, WS_VR)
#define F_GR FWS(bf16_t, WS_GR)
#define F_MIX FWS(bf16_t, WS_MIX)
#define F_H FWS(bf16_t, WS_H)
#define F_KV FWS(float, WS_KV)
#define F_X1 FWS(float, WS_X1)
#define F_RSS FWS(float, WS_RSS)
#define F_RSSS FWS(float, WS_RSSS)
#define F_SHB FWS(bf16_t, WS_SHB)
#define F_SHW FWS(float, WS_SHW)

__device__ __forceinline__ unsigned f2bf(float f) { unsigned u = __builtin_bit_cast(unsigned, f); return (u + 0x7fffu + ((u >> 16) & 1u)) >> 16; }
__device__ __forceinline__ unsigned pk2(float lo, float hi) { return f2bf(lo) | (f2bf(hi) << 16); }
__device__ __forceinline__ void p0_transpose_item(const float* W, int K, int N, bf16_t* WT, LAS float* scr, int item, int lane) {
    const int nblk = N / 32, kb = item / nblk, nb = item % nblk, k0 = 64 * kb, n0 = 32 * nb;
    f32x4 v[8];
#pragma unroll
    for (int i = 0; i < 8; ++i) v[i] = *(const f32x4*)(W + (size_t)(k0 + 8 * i + (lane >> 3)) * N + n0 + 4 * (lane & 7));
#pragma unroll
    for (int i = 0; i < 8; ++i) { LAS float* d = scr + (8 * i + (lane >> 3)) * 33 + 4 * (lane & 7); d[0] = v[i].x; d[1] = v[i].y; d[2] = v[i].z; d[3] = v[i].w; }
    asm volatile("s_waitcnt lgkmcnt(0)" ::: "memory");
    const int c = lane & 7;
#pragma unroll
    for (int j = 0; j < 4; ++j) { const int n = (lane >> 3) + 8 * j; const LAS float* sp = scr + (8 * c) * 33 + n;
        u32x4 o; o.x = pk2(sp[0 * 33], sp[1 * 33]); o.y = pk2(sp[2 * 33], sp[3 * 33]); o.z = pk2(sp[4 * 33], sp[5 * 33]); o.w = pk2(sp[6 * 33], sp[7 * 33]);
        *(u32x4*)(WT + (size_t)(n0 + n) * K + k0 + 8 * c) = o; }
    asm volatile("s_waitcnt lgkmcnt(0)" ::: "memory");
}
__device__ __forceinline__ void sincos_d(double x, float& sn, float& cs) {
    const double k = __builtin_rint(x * 0.63661977236758134308);
    double r = __builtin_fma(-k, 1.57079632679489655800e+00, x); r = __builtin_fma(-k, 6.12323399573676603587e-17, r);
    const double r2 = r * r;
    double s = -7.6471637318198164759e-13; s = s * r2 + 1.6059043836821614599e-10; s = s * r2 - 2.5052108385441718775e-08; s = s * r2 + 2.7557319223985890653e-06;
    s = s * r2 - 1.9841269841269841270e-04; s = s * r2 + 8.3333333333333333333e-03; s = s * r2 - 1.6666666666666666667e-01; s = r + r * r2 * s;
    double c = 4.7794773323873852974e-14; c = c * r2 - 1.1470745597729724714e-11; c = c * r2 + 2.0876756987868098979e-09; c = c * r2 - 2.7557319223985890653e-07;
    c = c * r2 + 2.4801587301587301587e-05; c = c * r2 - 1.3888888888888888889e-03; c = c * r2 + 4.1666666666666666667e-02; c = c * r2 - 0.5; c = 1.0 + r2 * c;
    const int q = ((int)k) & 3;
    const double ss = (q == 0) ? s : (q == 1) ? c : (q == 2) ? -s : -c;
    const double cc = (q == 0) ? c : (q == 1) ? -s : (q == 2) ? -c : s;
    sn = (float)ss; cs = (float)cc;
}
__device__ __forceinline__ void p0_prologue(Frame& F) {
    {
        const int w = F.wave, lane = F.lane, hh = lane >> 5, cl = lane & 31;
        LAS float* sst = (LAS float*)(F.lds + w * 16384);
        for (int item = F.vcu; item < 256; item += F.G) {
            const bool fin = item >= 192; const int col = (fin ? item - 192 : item) * 32 + cl;
            const float* W = fin ? F_w_adaf : F_w_ada; const int ldw = fin ? 2048 : 6144;
            float acc[NMODB];
#pragma unroll
            for (int r = 0; r < NMODB; ++r) acc[r] = 0.f;
            const int kbase = 128 * w + 64 * hh;
            const int skk = lane & 15, srs = (lane >> 4) & 1;
            const float* cpb = F_cp + srs * D + kbase + skk; const float* csb = F_cs + (srs - NB) * D + kbase + skk;
            LAS float* sdst = sst + hh * 640 + srs * 16 + skk;
            float wn[16];
#define ADA_LOADW(rd) do { _Pragma("unroll") for (int kk = 0; kk < 16; ++kk) wn[kk] = W[(size_t)(kbase + 16 * (rd) + kk) * ldw + col]; } while (0)
            ADA_LOADW(0);
#pragma unroll 1
            for (int rd = 0; rd < 4; ++rd) {
                float wc_[16];
#pragma unroll
                for (int kk = 0; kk < 16; ++kk) wc_[kk] = wn[kk];
                {
                    float cn[20];
#pragma unroll
                    for (int i = 0; i < 20; ++i) cn[i] = (i < 4) ? cpb[2 * i * D + 16 * rd] : csb[2 * i * D + 16 * rd];
#pragma unroll
                    for (int i = 0; i < 20; ++i) sdst[32 * i] = cn[i] * __builtin_amdgcn_rcpf(1.0f + __builtin_amdgcn_exp2f(-1.4426950408889634f * cn[i]));
                }
                __builtin_amdgcn_sched_barrier(0);
                if (rd < 3) ADA_LOADW(rd + 1);
                asm volatile("s_waitcnt lgkmcnt(0)" ::: "memory");
                __builtin_amdgcn_sched_barrier(0);
#pragma unroll
                for (int r = 0; r < NMODB; ++r) {
                    const LAS f32x4* sp = (const LAS f32x4*)(sst + hh * 640 + r * 16);
                    const f32x4 s0 = sp[0], s1 = sp[1], s2 = sp[2], s3 = sp[3];
                    float t = acc[r];
                    t += s0.x * wc_[0] + s0.y * wc_[1] + s0.z * wc_[2] + s0.w * wc_[3];
                    t += s1.x * wc_[4] + s1.y * wc_[5] + s1.z * wc_[6] + s1.w * wc_[7];
                    t += s2.x * wc_[8] + s2.y * wc_[9] + s2.z * wc_[10] + s2.w * wc_[11];
                    t += s3.x * wc_[12] + s3.y * wc_[13] + s3.z * wc_[14] + s3.w * wc_[15];
                    acc[r] = t;
                    if ((r & 1) == 1) { asm volatile("" ::: "memory"); __builtin_amdgcn_sched_barrier(0); }
                }
                asm volatile("s_waitcnt lgkmcnt(0)" ::: "memory");
            }
#undef ADA_LOADW
            __syncthreads();
            LAS float* red = (LAS float*)F.lds;
#pragma unroll
            for (int r = 0; r < NMODB; ++r) red[((2 * w + hh) * NMODB + r) * 32 + cl] = acc[r];
            __syncthreads();
            for (int o = F.tid; o < NMODB * 32; o += NTHREADS) { const int r = o >> 5, c2 = o & 31; float sum = 0.f;
#pragma unroll
                for (int p = 0; p < 16; ++p) sum += red[(p * NMODB + r) * 32 + c2];
                const int oc = (fin ? item - 192 : item) * 32 + c2;
                if (fin) F_MODF[r * 2048 + oc] = sum + F_b_adaf[oc]; else F_MOD[r * 6144 + oc] = sum + F_b_ada[oc]; }
            __syncthreads();
        }
    }
    {
        LAS float* scr = (LAS float*)(F.lds + F.wave * 16384);
        const int gw = F.vcu * NWAVES + F.wave, NGW = F.G * NWAVES;
        constexpr int I_IN = (D / 64) * (NIN / 32), I_O = (D / 64) * (D / 32), I_1 = (D / 64) * (FF / 32), I_2 = (FF / 64) * (D / 32);
        constexpr int NITEMS = I_IN + I_O + I_1 + I_2;
        for (int it = gw; it < NITEMS; it += NGW) {
            int r = it;
            if (r < I_IN) { p0_transpose_item(F_w_in, D, NIN, F_WIN, scr, r, F.lane); continue; } r -= I_IN;
            if (r < I_O) { p0_transpose_item(F_w_out, D, D, F_WOUT, scr, r, F.lane); continue; } r -= I_O;
            if (r < I_1) { p0_transpose_item(F_w_ff1, D, FF, F_W1, scr, r, F.lane); continue; } r -= I_1;
            p0_transpose_item(F_w_ff2, FF, D, F_W2, scr, r, F.lane);
        }
    }
    {
        const int gt = F.vcu * NTHREADS + F.tid, NT = F.G * NTHREADS;
        for (int i = gt; i < 2056 * 40; i += NT) { const int p = i / 40, j = i % 40; const int pos = p < 2048 ? p : 8192 + (p - 2048);
            float sn, cs; sincos_d((double)pos * INVF[j], sn, cs);
            if (j < 8) F_TABR[p * 8 + j] = (f32x2){cs, sn}; else F_TABT[p * 32 + (j - 8)] = (f32x2){cs, sn}; }
    }
}

template <int MODE> __device__ __forceinline__ void norm_rows(Frame& F) {
    const int gw = F.vcu * NWAVES + F.wave, NGW = F.G * NWAVES;
    for (int m0 = gw; m0 < M; m0 += 2 * NGW) {
        const int m1 = m0 + NGW; const bool two = m1 < M; const int mb = two ? m1 : m0;
        const float* xa = MODE == 0 ? (m0 < MP ? F_xp + (size_t)m0 * D : F_xs + (size_t)(m0 - MP) * D) : F_X1 + (size_t)m0 * D;
        const float* xb = MODE == 0 ? (mb < MP ? F_xp + (size_t)mb * D : F_xs + (size_t)(mb - MP) * D) : F_X1 + (size_t)mb * D;
        f32x4 va[4], vb[4]; float sa = 0.f, sb = 0.f;
#pragma unroll
        for (int j = 0; j < 4; ++j) { va[j] = ((const f32x4*)xa)[F.lane + 64 * j]; vb[j] = ((const f32x4*)xb)[F.lane + 64 * j]; }
#pragma unroll
        for (int j = 0; j < 4; ++j) { sa += (va[j].x * va[j].x + va[j].y * va[j].y) + (va[j].z * va[j].z + va[j].w * va[j].w); sb += (vb[j].x * vb[j].x + vb[j].y * vb[j].y) + (vb[j].z * vb[j].z + vb[j].w * vb[j].w); }
        const float ra = 1.0f / sqrtf(wave_sum(sa) * (1.f / D) + EPS), rb = 1.0f / sqrtf(wave_sum(sb) * (1.f / D) + EPS);
#pragma unroll
        for (int t = 0; t < 2; ++t) {
            if (t == 1 && !two) break;
            const int m = t == 0 ? m0 : m1; const float rstd = t == 0 ? ra : rb;
            const int bi = row_bidx(m);
            const float* shp = MODE == 0 ? F_MOD + (size_t)bi * 6144 : MODE == 1 ? F_MOD + (size_t)bi * 6144 + 3072 : F_MODF + (size_t)bi * 2048;
            const float* scp = shp + 1024;
#pragma unroll
            for (int j = 0; j < 4; ++j) {
                const f32x4 sh = ((const f32x4*)shp)[F.lane + 64 * j], sc = ((const f32x4*)scp)[F.lane + 64 * j];
                const f32x4 o = (t == 0 ? va[j] : vb[j]) * rstd * (sc + 1.0f) + sh;
                if constexpr (MODE == 2) ((f32x4*)(F_out + OFF_Y + (size_t)m * D))[F.lane + 64 * j] = o;
                else { u32x2 w; w.x = cvtpk(o.x, o.y); w.y = cvtpk(o.z, o.w); ((u32x2*)(F_XN + (size_t)m * D))[F.lane + 64 * j] = w; }
            }
        }
    }
}

typedef short v4i16_t __attribute__((ext_vector_type(4)));
template <bool PERMK> __device__ __forceinline__ bf16x8 trfrag(LAS const unsigned char* img, int k0, int lane) {
    const int hi = lane >> 5, gb = (lane >> 4) & 1, q = (lane >> 2) & 3, p = lane & 3;
    const int ra = PERMK ? (k0 + 4 * hi + q) : (k0 + 8 * hi + q), rb = PERMK ? (ra + 8) : (ra + 4);
    LAS const unsigned char* pa = img + ra * 64 + (16 * gb + 4 * p) * 2; LAS const unsigned char* pb = img + rb * 64 + (16 * gb + 4 * p) * 2;
    const s16x4 lo = __builtin_bit_cast(s16x4, __builtin_amdgcn_ds_read_tr16_b64_v4i16((LAS v4i16_t*)pa));
    const s16x4 h4 = __builtin_bit_cast(s16x4, __builtin_amdgcn_ds_read_tr16_b64_v4i16((LAS v4i16_t*)pb));
    return (bf16x8){lo[0], lo[1], lo[2], lo[3], h4[0], h4[1], h4[2], h4[3]};
}
__device__ __forceinline__ bf16x8 pack8(float a0, float a1, float a2, float a3, float a4, float a5, float a6, float a7) {
    u32x4 w; w.x = cvtpk(a0, a1); w.y = cvtpk(a2, a3); w.z = cvtpk(a4, a5); w.w = cvtpk(a6, a7); return __builtin_bit_cast(bf16x8, w);
}
__device__ __forceinline__ bf16x8 ld8_bf16(const bf16_t* p) { return *(const bf16x8*)p; }
__device__ __forceinline__ bf16x8 ld8_f32(const float* p) { const f32x4 a = *(const f32x4*)p, b = *(const f32x4*)(p + 4); return pack8(a.x, a.y, a.z, a.w, b.x, b.y, b.z, b.w); }

struct AttnAcc { f32x16 o0, o1; float m, l; };
template <int BR, bool EXCL, bool QMASK>
__device__ __forceinline__ void attn_step(AttnAcc& A, const bf16x8 (&kf)[4], const bf16x8 (&qf)[4], LAS const unsigned char* vimg, int qp, bool qvalid, int p0, int s_hi, int s_lo, int lane) {
    const int hi = lane >> 5;
    f32x16 s = {0.f, 0.f, 0.f, 0.f, 0.f, 0.f, 0.f, 0.f, 0.f, 0.f, 0.f, 0.f, 0.f, 0.f, 0.f, 0.f};
#pragma unroll
    for (int d0 = 0; d0 < 4; ++d0) s = __builtin_amdgcn_mfma_f32_32x32x16_bf16(kf[d0], qf[d0], s, 0, 0, 0);
    const int pbase = p0 + 4 * hi * s_lo, dbase = qp - pbase;
    float mu[16]; float tmax = -1e30f;
#pragma unroll
    for (int r = 0; r < 16; ++r) {
        const int off = (r >> 2) * s_hi + (r & 3) * s_lo, dist = dbase - off, pos = pbase + off;
        int ml = 0;
        if (BR & 1) ml += (dist <= 128) ? 1 : 0;
        if (BR & 2) ml += ((dist & 3) == 0 && dist <= 512) ? 1 : 0;
        if (BR & 4) ml += ((dist & 15) == 0 && dist <= 2048) ? 1 : 0;
        if (EXCL && (dist & 15) == 0) ml = 0;
        if (dist < 0 || pos < 0) ml = 0;
        if (QMASK && !qvalid) ml = 0;
        mu[r] = (float)ml;
        s[r] = ml ? s[r] : -1e30f; tmax = fmaxf(tmax, s[r]);
    }
    tmax = fmaxf(tmax, __shfl_xor(tmax, 32));
    const float mn = fmaxf(A.m, tmax), alpha = __builtin_amdgcn_exp2f(A.m - mn); A.m = mn;
    float ps = 0.f;
#pragma unroll
    for (int r = 0; r < 16; ++r) { s[r] = mu[r] * __builtin_amdgcn_exp2f(s[r] - mn); ps += s[r]; }
    A.l = A.l * alpha + ps;
    A.o0 = A.o0 * alpha; A.o1 = A.o1 * alpha;
    const bf16x8 pf0 = pack8(s[0], s[1], s[2], s[3], s[4], s[5], s[6], s[7]), pf1 = pack8(s[8], s[9], s[10], s[11], s[12], s[13], s[14], s[15]);
    A.o0 = __builtin_amdgcn_mfma_f32_32x32x16_bf16(trfrag<true>(vimg, 0, lane), pf0, A.o0, 0, 0, 0);
    A.o0 = __builtin_amdgcn_mfma_f32_32x32x16_bf16(trfrag<true>(vimg, 16, lane), pf1, A.o0, 0, 0, 0);
    A.o1 = __builtin_amdgcn_mfma_f32_32x32x16_bf16(trfrag<true>(vimg + 2048, 0, lane), pf0, A.o1, 0, 0, 0);
    A.o1 = __builtin_amdgcn_mfma_f32_32x32x16_bf16(trfrag<true>(vimg + 2048, 16, lane), pf1, A.o1, 0, 0, 0);
}
template <bool F32SRC> struct TileRegs { bf16x8 kf[4]; bf16x8 vs[4]; };
template <bool F32SRC> __device__ __forceinline__ void tile_load(TileRegs<F32SRC>& T, const void* kb, const void* vb, long rowbase, int pmax, int p0, int s_hi, int s_lo, int lane) {
    const int r32 = lane & 31, hi = lane >> 5;
    int pk = p0 + (r32 >> 3) * s_hi + (r32 & 7) * s_lo; pk = pk < 0 ? 0 : (pk > pmax ? pmax : pk);
    const int kv = lane >> 1; int pv = p0 + (kv >> 3) * s_hi + (kv & 7) * s_lo; pv = pv < 0 ? 0 : (pv > pmax ? pmax : pv);
    if constexpr (F32SRC) {
        const float* kr = (const float*)kb + (rowbase + pk) * 512 + 8 * hi; const float* vr = (const float*)vb + (rowbase + pv) * 512 + 32 * (lane & 1);
#pragma unroll
        for (int d0 = 0; d0 < 4; ++d0) T.kf[d0] = ld8_f32(kr + 16 * d0);
#pragma unroll
        for (int j = 0; j < 4; ++j) T.vs[j] = ld8_f32(vr + 8 * j);
    } else {
        const bf16_t* kr = (const bf16_t*)kb + (rowbase + pk) * 512 + 8 * hi; const bf16_t* vr = (const bf16_t*)vb + (rowbase + pv) * 512 + 32 * (lane & 1);
#pragma unroll
        for (int d0 = 0; d0 < 4; ++d0) T.kf[d0] = ld8_bf16(kr + 16 * d0);
#pragma unroll
        for (int j = 0; j < 4; ++j) T.vs[j] = ld8_bf16(vr + 8 * j);
    }
}
template <bool F32SRC> __device__ __forceinline__ void tile_stage_v(const TileRegs<F32SRC>& T, LAS unsigned char* vimg, int lane) {
    LAS unsigned char* d = vimg + (lane & 1) * 2048 + (lane >> 1) * 64;
#pragma unroll
    for (int j = 0; j < 4; ++j) *(LAS bf16x8*)(d + 16 * j) = T.vs[j];
}
__device__ __forceinline__ void attn_store(const AttnAcc& A, bf16_t* mixrow, int lane) {
    const int hi = lane >> 5;
    const float lt = A.l + __shfl_xor(A.l, 32), inv = 1.0f / lt;
#pragma unroll
    for (int g = 0; g < 4; ++g) {
        u32x2 w0, w1; w0.x = cvtpk(A.o0[4 * g] * inv, A.o0[4 * g + 1] * inv); w0.y = cvtpk(A.o0[4 * g + 2] * inv, A.o0[4 * g + 3] * inv);
        w1.x = cvtpk(A.o1[4 * g] * inv, A.o1[4 * g + 1] * inv); w1.y = cvtpk(A.o1[4 * g + 2] * inv, A.o1[4 * g + 3] * inv);
        *(u32x2*)(mixrow + 8 * g + 4 * hi) = w0; *(u32x2*)(mixrow + 32 + 8 * g + 4 * hi) = w1;
    }
}
#define WAVE_LDS_FENCE() asm volatile("s_waitcnt lgkmcnt(0)" ::: "memory")

__device__ __forceinline__ void prompt_attn_tile(Frame& F, int b, int h, int rho, int c, LAS unsigned char* vimg) {
    const int lane = F.lane, r32 = lane & 31, hi = lane >> 5;
    const int T0 = 512 * c + rho, qp = T0 + 16 * r32;
    const long rowbase = (long)b * SEQ;
    const bf16_t* Qp = F_QA + h * 64; const bf16_t* Kp = F_KA + h * 64; const bf16_t* Vp = F_VA + h * 64;
    bf16x8 qf[4];
#pragma unroll
    for (int d0 = 0; d0 < 4; ++d0) qf[d0] = ld8_bf16(Qp + (rowbase + qp) * 512 + 16 * d0 + 8 * hi);
    AttnAcc A; A.m = -1e30f; A.l = 0.f;
#pragma unroll
    for (int r = 0; r < 16; ++r) { A.o0[r] = 0.f; A.o1[r] = 0.f; }
    TileRegs<false> T;
    for (int ti = 0; ti < 5; ++ti) { const int p0 = T0 - 2048 + 512 * ti; if (p0 + 496 < 0) continue;
        tile_load<false>(T, Kp, Vp, rowbase, SEQ - 1, p0, 128, 16, lane); tile_stage_v<false>(T, vimg, lane); WAVE_LDS_FENCE();
        attn_step<7, false, false>(A, T.kf, qf, vimg, qp, true, p0, 128, 16, lane); WAVE_LDS_FENCE(); }
    for (int ti = 0; ti < 3; ++ti) { const int p0 = T0 - 512 + 128 * ti; if (p0 + 124 < 0) continue;
        tile_load<false>(T, Kp, Vp, rowbase, SEQ - 1, p0, 32, 4, lane); tile_stage_v<false>(T, vimg, lane); WAVE_LDS_FENCE();
        attn_step<7, true, false>(A, T.kf, qf, vimg, qp, true, p0, 32, 4, lane); WAVE_LDS_FENCE(); }
    for (int ti = 0; ti < 20; ++ti) { const int p0 = T0 - 128 + 32 * ti; if (p0 + 31 < 0 || p0 > SEQ - 1) continue;
        tile_load<false>(T, Kp, Vp, rowbase, SEQ - 1, p0, 8, 1, lane); tile_stage_v<false>(T, vimg, lane); WAVE_LDS_FENCE();
        attn_step<7, true, false>(A, T.kf, qf, vimg, qp, true, p0, 8, 1, lane); WAVE_LDS_FENCE(); }
    attn_store(A, F_MIX + (rowbase + qp) * D + h * 64, lane);
}

__device__ __forceinline__ void sample_attn_item(Frame& F, int sb, int h) {
    const int lane = F.lane, r32 = lane & 31, hi = lane >> 5, w = F.wave;
    LAS unsigned char* vimg = F.lds + w * 4096;
    const bool qvalid = r32 < DT; const int qp = LCACHE + (qvalid ? r32 : 0);
    bf16x8 qf[4];
#pragma unroll
    for (int d0 = 0; d0 < 4; ++d0) qf[d0] = ld8_bf16(F_QA + (size_t)(MP + sb * DT + (qvalid ? r32 : 0)) * 512 + h * 64 + 16 * d0 + 8 * hi);
    AttnAcc A; A.m = -1e30f; A.l = 0.f;
#pragma unroll
    for (int r = 0; r < 16; ++r) { A.o0[r] = 0.f; A.o1[r] = 0.f; }
    for (int ti = w; ti < 41; ti += NWAVES) {
        if (ti == 0) {
            TileRegs<false> T; tile_load<false>(T, F_KA + h * 64, F_VA + h * 64, (long)(MP + sb * DT) - LCACHE, LCACHE + DT - 1, LCACHE, 8, 1, lane);
            tile_stage_v<false>(T, vimg, lane); WAVE_LDS_FENCE();
            attn_step<7, false, true>(A, T.kf, qf, vimg, qp, qvalid, LCACHE, 8, 1, lane); WAVE_LDS_FENCE();
        } else {
            const int p0 = ti <= 16 ? (LCACHE - 512 + 32 * (ti - 1)) : 64 * (ti - 17); const int s_hi = ti <= 16 ? 8 : 16;
            TileRegs<true> T; tile_load<true>(T, F_ck + h * 64, F_cv + h * 64, (long)sb * LCACHE, LCACHE - 1, p0, s_hi, 1, lane);
            tile_stage_v<true>(T, vimg, lane); WAVE_LDS_FENCE();
            attn_step<7, false, true>(A, T.kf, qf, vimg, qp, qvalid, p0, s_hi, 1, lane); WAVE_LDS_FENCE();
        }
    }
    LAS float* po = (LAS float*)(F.lds + 32768); LAS float* pm = po + 8 * 8 * 64; LAS float* pl = pm + 64;
    const float lt = A.l + __shfl_xor(A.l, 32);
    if (qvalid) {
#pragma unroll
        for (int g = 0; g < 4; ++g) {
            *(LAS f32x4*)(po + (w * 8 + r32) * 64 + 8 * g + 4 * hi) = (f32x4){A.o0[4 * g], A.o0[4 * g + 1], A.o0[4 * g + 2], A.o0[4 * g + 3]};
            *(LAS f32x4*)(po + (w * 8 + r32) * 64 + 32 + 8 * g + 4 * hi) = (f32x4){A.o1[4 * g], A.o1[4 * g + 1], A.o1[4 * g + 2], A.o1[4 * g + 3]};
        }
        if (hi == 0) { pm[w * 8 + r32] = A.m; pl[w * 8 + r32] = lt; }
    }
    __syncthreads();
    {
        const int q = F.tid >> 6, d = F.tid & 63;
        float mm = -1e30f;
#pragma unroll
        for (int ww = 0; ww < 8; ++ww) mm = fmaxf(mm, pm[ww * 8 + q]);
        float L = 0.f, O = 0.f;
#pragma unroll
        for (int ww = 0; ww < 8; ++ww) { const float f = __builtin_amdgcn_exp2f(pm[ww * 8 + q] - mm); L += pl[ww * 8 + q] * f; O += po[(ww * 8 + q) * 64 + d] * f; }
        const float o = O / L;
        F_MIX[(size_t)(MP + sb * DT + q) * D + h * 64 + d] = (bf16_t)f2bf(o);
    }
    __syncthreads();
}

__device__ __forceinline__ void ret_kv_item(Frame& F, int b, int h, int j) {
    const int tid = F.tid, lane = F.lane, w = F.wave;
    LAS unsigned char* kimg = F.lds;
    LAS unsigned char* vimg = F.lds + 16384;
    const size_t R0 = (size_t)b * SEQ + (size_t)j * 128;
    const float lg = log2g_of(h);
#pragma unroll
    for (int i = 0; i < 2; ++i) { const int id = tid + NTHREADS * i, row = id >> 3, ch = id & 7;
        const bf16x8 v = *(const bf16x8*)(F_KR + (R0 + row) * 256 + h * 64 + 8 * ch);
        *(LAS bf16x8*)(kimg + (ch >> 2) * 8192 + row * 64 + (ch & 3) * 16) = v; }
#pragma unroll
    for (int i = 0; i < 4; ++i) { const int id = tid + NTHREADS * i, row = id >> 4, ch = id & 15;
        const u32x4 v = *(const u32x4*)(F_VR + (R0 + row) * 512 + h * 128 + 8 * ch);
        const float sc = __builtin_amdgcn_exp2f((float)(127 - row) * lg);
        u32x4 o; o.x = cvtpk(bflo(v.x) * sc, bfhi(v.x) * sc); o.y = cvtpk(bflo(v.y) * sc, bfhi(v.y) * sc); o.z = cvtpk(bflo(v.z) * sc, bfhi(v.z) * sc); o.w = cvtpk(bflo(v.w) * sc, bfhi(v.w) * sc);
        *(LAS u32x4*)(vimg + (ch >> 2) * 8192 + row * 64 + (ch & 3) * 16) = o; }
    __syncthreads();
    const int db = w >> 2, eb = w & 3;
    f32x16 acc;
#pragma unroll
    for (int r = 0; r < 16; ++r) acc[r] = 0.f;
#pragma unroll
    for (int s = 0; s < 8; ++s)
        acc = __builtin_amdgcn_mfma_f32_32x32x16_bf16(trfrag<false>(kimg + db * 8192, 16 * s, lane), trfrag<false>(vimg + eb * 8192, 16 * s, lane), acc, 0, 0, 0);
    float* kvo = F_KV + ((size_t)((b * 4 + h) * 16 + j)) * 8192;
    const int r32 = lane & 31, hi = lane >> 5;
#pragma unroll
    for (int r = 0; r < 16; ++r) { const int d = 32 * db + (r & 3) + 8 * (r >> 2) + 4 * hi; kvo[d * 128 + 32 * eb + r32] = acc[r]; }
    __syncthreads();
}
__device__ __forceinline__ void ret_out_item(Frame& F, int b, int h, int c) {
    const int tid = F.tid, lane = F.lane, w = F.wave, r32 = lane & 31, hi = lane >> 5;
    LAS unsigned char* vimg = F.lds;
    LAS unsigned char* simg = F.lds + 32768;
    LAS float* stat = (LAS float*)(F.lds + 49152);
    const size_t R0 = (size_t)b * SEQ + (size_t)c * 128;
    const float lg = log2g_of(h), gam = __builtin_amdgcn_exp2f(128.f * lg);
#pragma unroll
    for (int i = 0; i < 4; ++i) { const int id = tid + NTHREADS * i, row = id >> 4, ch = id & 15;
        const bf16x8 v = *(const bf16x8*)(F_VR + (R0 + row) * 512 + h * 128 + 8 * ch);
        *(LAS bf16x8*)(vimg + (ch >> 2) * 8192 + row * 64 + (ch & 3) * 16) = v; }
    {
        const float* kvb = F_KV + (size_t)((b * 4 + h) * 16) * 8192;
        f32x4 S[4];
#pragma unroll
        for (int i = 0; i < 4; ++i) S[i] = (f32x4){0.f, 0.f, 0.f, 0.f};
#pragma unroll 4
        for (int j = 0; j < c; ++j) {
#pragma unroll
            for (int i = 0; i < 4; ++i) S[i] = S[i] * gam + *(const f32x4*)(kvb + (size_t)j * 8192 + 4 * (tid + NTHREADS * i));
        }
#pragma unroll
        for (int i = 0; i < 4; ++i) { const int gi = tid + NTHREADS * i, d = gi >> 5, e0 = (gi & 31) * 4;
            u32x2 o; o.x = cvtpk(S[i].x, S[i].y); o.y = cvtpk(S[i].z, S[i].w);
            *(LAS u32x2*)(simg + (e0 >> 5) * 4096 + d * 64 + (e0 & 31) * 2) = o; }
        if (c == 15) {
            float* rp = F_out + OFF_RP + (size_t)(b * 4 + h) * 8192;
#pragma unroll
            for (int i = 0; i < 4; ++i) { const f32x4 fin = S[i] * gam + *(const f32x4*)(kvb + (size_t)15 * 8192 + 4 * (tid + NTHREADS * i)); *(f32x4*)(rp + 4 * (tid + NTHREADS * i)) = fin; }
        }
    }
    __syncthreads();
    const int wq = w >> 1, we = w & 1;
    const int q = 32 * wq + r32;
    bf16x8 qf[4];
#pragma unroll
    for (int s = 0; s < 4; ++s) qf[s] = ld8_bf16(F_QR + (R0 + q) * 256 + h * 64 + 16 * s + 8 * hi);
    f32x16 o[2];
#pragma unroll
    for (int r = 0; r < 16; ++r) { o[0][r] = 0.f; o[1][r] = 0.f; }
#pragma unroll
    for (int eb = 0; eb < 2; ++eb)
#pragma unroll
        for (int s = 0; s < 4; ++s) o[eb] = __builtin_amdgcn_mfma_f32_32x32x16_bf16(trfrag<false>(simg + (2 * we + eb) * 4096, 16 * s, lane), qf[s], o[eb], 0, 0, 0);
    { const float gq = __builtin_amdgcn_exp2f((float)(q + 1) * lg); o[0] = o[0] * gq; o[1] = o[1] * gq; }
    for (int jb = 0; jb <= wq; ++jb) {
        bf16x8 kf[4];
#pragma unroll
        for (int s = 0; s < 4; ++s) kf[s] = ld8_bf16(F_KR + (R0 + 32 * jb + r32) * 256 + h * 64 + 16 * s + 8 * hi);
        f32x16 st;
#pragma unroll
        for (int r = 0; r < 16; ++r) st[r] = 0.f;
#pragma unroll
        for (int s = 0; s < 4; ++s) st = __builtin_amdgcn_mfma_f32_32x32x16_bf16(kf[s], qf[s], st, 0, 0, 0);
#pragma unroll
        for (int r = 0; r < 16; ++r) { const int key = 32 * jb + (r & 3) + 8 * (r >> 2) + 4 * hi, dl = q - key;
            st[r] = dl >= 0 ? st[r] * __builtin_amdgcn_exp2f((float)dl * lg) : 0.f; }
        const bf16x8 pf0 = pack8(st[0], st[1], st[2], st[3], st[4], st[5], st[6], st[7]), pf1 = pack8(st[8], st[9], st[10], st[11], st[12], st[13], st[14], st[15]);
#pragma unroll
        for (int eb = 0; eb < 2; ++eb) {
            o[eb] = __builtin_amdgcn_mfma_f32_32x32x16_bf16(trfrag<true>(vimg + (2 * we + eb) * 8192, 32 * jb, lane), pf0, o[eb], 0, 0, 0);
            o[eb] = __builtin_amdgcn_mfma_f32_32x32x16_bf16(trfrag<true>(vimg + (2 * we + eb) * 8192, 32 * jb + 16, lane), pf1, o[eb], 0, 0, 0);
        }
    }
    float sm = 0.f, sq = 0.f;
#pragma unroll
    for (int r = 0; r < 16; ++r) { sm += o[0][r] + o[1][r]; sq += o[0][r] * o[0][r] + o[1][r] * o[1][r]; }
    sm += __shfl_xor(sm, 32); sq += __shfl_xor(sq, 32);
    if (hi == 0) { stat[(w * 32 + r32) * 2] = sm; stat[(w * 32 + r32) * 2 + 1] = sq; }
    __syncthreads();
    sm += stat[((w ^ 1) * 32 + r32) * 2]; sq += stat[((w ^ 1) * 32 + r32) * 2 + 1];
    const float mean = sm * (1.f / 128.f), var = sq * (1.f / 128.f) - mean * mean, rstd = 1.0f / sqrtf(fmaxf(var, 0.f) + EPS);
    const size_t grow = (R0 + q);
#pragma unroll
    for (int eb = 0; eb < 2; ++eb)
#pragma unroll
        for (int g = 0; g < 4; ++g) {
            const int e = 64 * we + 32 * eb + 8 * g + 4 * hi;
            const f32x4 gn = *(const f32x4*)(F_gain + h * 128 + e);
            const u32x2 sg = *(const u32x2*)(F_GR + grow * 512 + h * 128 + e);
            const float y0 = (o[eb][4 * g] - mean) * rstd * gn.x * bflo(sg.x), y1 = (o[eb][4 * g + 1] - mean) * rstd * gn.y * bfhi(sg.x);
            const float y2 = (o[eb][4 * g + 2] - mean) * rstd * gn.z * bflo(sg.y), y3 = (o[eb][4 * g + 3] - mean) * rstd * gn.w * bfhi(sg.y);
            u32x2 wv; wv.x = cvtpk(y0, y1); wv.y = cvtpk(y2, y3);
            *(u32x2*)(F_MIX + grow * D + 512 + h * 128 + e) = wv;
        }
    __syncthreads();
}
__device__ __forceinline__ void ret_sample_item(Frame& F, int sb, int h) {
    const int tid = F.tid;
    LAS float* q = (LAS float*)F.lds;
    LAS float* k = q + 512;
    LAS float* v = k + 512;
    LAS float* sg = v + 1024;
    LAS float* sc = sg + 1024;
    LAS float* ob = sc + 64;
    const size_t R0 = (size_t)MP + (size_t)sb * DT;
    const float lg = log2g_of(h);
    { const int i = tid >> 6, d = tid & 63; q[tid] = bf2f(F_QR[(R0 + i) * 256 + h * 64 + d]); k[tid] = bf2f(F_KR[(R0 + i) * 256 + h * 64 + d]); }
#pragma unroll
    for (int x = 0; x < 2; ++x) { const int id = tid + NTHREADS * x, i = id >> 7, e = id & 127; v[id] = bf2f(F_VR[(R0 + i) * 512 + h * 128 + e]); sg[id] = bf2f(F_GR[(R0 + i) * 512 + h * 128 + e]); }
    __syncthreads();
    if (tid < 64) { const int i = tid >> 3, j = tid & 7; float s = 0.f;
        for (int d = 0; d < 64; ++d) s += q[i * 64 + d] * k[j * 64 + d];
        sc[tid] = (i >= j) ? s * __builtin_amdgcn_exp2f((float)(i - j) * lg) : 0.f; }
    __syncthreads();
    const float* st0 = F_st + (size_t)(sb * 4 + h) * 8192;
    {
        const int e = tid & 127, ih = tid >> 7;
        float c0 = 0.f, c1 = 0.f;
        for (int d = 0; d < 64; ++d) { const float s0 = st0[d * 128 + e]; c0 += q[ih * 64 + d] * s0; c1 += q[(ih + 4) * 64 + d] * s0; }
        float i0 = 0.f, i1 = 0.f;
#pragma unroll
        for (int j = 0; j < 8; ++j) { i0 += sc[ih * 8 + j] * v[j * 128 + e]; i1 += sc[(ih + 4) * 8 + j] * v[j * 128 + e]; }
        ob[ih * 128 + e] = i0 + c0 * __builtin_amdgcn_exp2f((float)(ih + 1) * lg);
        ob[(ih + 4) * 128 + e] = i1 + c1 * __builtin_amdgcn_exp2f((float)(ih + 5) * lg);
    }
    {
        float* rs = F_out + OFF_RS + (size_t)(sb * 4 + h) * 8192; const float g8 = __builtin_amdgcn_exp2f(8.f * lg);
#pragma unroll
        for (int x = 0; x < 4; ++x) { const int gi = tid + NTHREADS * x, d = gi >> 5, e0 = (gi & 31) * 4;
            f32x4 s = *(const f32x4*)(st0 + d * 128 + e0) * g8;
#pragma unroll
            for (int j = 0; j < 8; ++j) { const float kd = k[j * 64 + d] * __builtin_amdgcn_exp2f((float)(7 - j) * lg); const f32x4 vv = *(const LAS f32x4*)(v + j * 128 + e0); s = s + vv * kd; }
            *(f32x4*)(rs + d * 128 + e0) = s; }
    }
    __syncthreads();
    { const int i = F.wave, lane = F.lane;
        const float a = ob[i * 128 + lane], b2 = ob[i * 128 + 64 + lane];
        const float mean = wave_sum(a + b2) * (1.f / 128.f);
        const float da = a - mean, db = b2 - mean; const float var = wave_sum(da * da + db * db) * (1.f / 128.f), rstd = 1.0f / sqrtf(var + EPS);
        bf16_t* mr = F_MIX + (R0 + i) * D + 512 + h * 128;
        mr[lane] = (bf16_t)f2bf(da * rstd * F_gain[h * 128 + lane] * sg[i * 128 + lane]);
        mr[64 + lane] = (bf16_t)f2bf(db * rstd * F_gain[h * 128 + 64 + lane] * sg[i * 128 + 64 + lane]); }
    __syncthreads();
}


#define XB_TMO      128
#define XB_XCNT(j)  (256  + 64 * (j))
#define XB_XSUB(j)  (1280 + 64 * (j))
#define XB_XGEN(j)  (2304 + 64 * (j))
#define XB_TOP      3328
#define XB_TOPGEN   3392
#define XCD_BAR_WORDS 3456
#define XB_SPIN_CAP (1u << 20)
__device__ __forceinline__ unsigned xb_ld(unsigned* p)              { return __hip_atomic_load(p, __ATOMIC_RELAXED, __HIP_MEMORY_SCOPE_AGENT); }
__device__ __forceinline__ unsigned xb_add(unsigned* p, unsigned v) { return __hip_atomic_fetch_add(p, v, __ATOMIC_RELAXED, __HIP_MEMORY_SCOPE_AGENT); }
__device__ __forceinline__ unsigned xb_xcc_id() { return (unsigned)__builtin_amdgcn_s_getreg((3 << 11) | 20) & 0xFu; }
#define XB_SPIN(cond, bar) do { unsigned _sp = 0; while (cond) { __builtin_amdgcn_s_sleep(1); \
    if ((++_sp & 255u) == 0u) { if (xb_ld(&(bar)[XB_TMO])) break; if (_sp > XB_SPIN_CAP) { atomicAdd(&(bar)[XB_TMO], 1u); break; } } } } while (0)
struct XcdBarrier { unsigned* bar; unsigned x; volatile LAS unsigned* st; };
__device__ __forceinline__ XcdBarrier xcd_barrier_post(unsigned* bar, volatile LAS unsigned* st) {
    XcdBarrier b; b.bar = bar; b.x = xb_xcc_id(); b.st = st;
    if (threadIdx.x == 0) (void)xb_add(&bar[XB_XCNT(b.x)], 1u);
    return b;
}
__device__ __forceinline__ void xcd_barrier_complete(unsigned* bar, unsigned x, unsigned& nloc, unsigned& nx) {
    const unsigned G = gridDim.x * gridDim.y * gridDim.z;
    unsigned sum, cnt, mine, sp = 0u;
    for (;;) {
        sum = 0u; cnt = 0u; mine = 0u;
#pragma unroll
        for (unsigned j = 0; j < 16; ++j) { const unsigned c = xb_ld(&bar[XB_XCNT(j)]); sum += c; cnt += (c > 0u) ? 1u : 0u; mine = (j == x) ? c : mine; }
        if (sum == G) break;
        __builtin_amdgcn_s_sleep(1);
        if ((++sp & 255u) == 0u) { if (xb_ld(&bar[XB_TMO])) break; if (sp > XB_SPIN_CAP) { atomicAdd(&bar[XB_TMO], 1u); break; } }
    }
    nloc = mine > 0u ? mine : 1u; nx = cnt > 0u ? cnt : 1u;
}
__device__ __forceinline__ void xcd_barrier(const XcdBarrier& b) {
    asm volatile("s_waitcnt vmcnt(0)" ::: "memory");
    __syncthreads();
    if (threadIdx.x == 0) {
        unsigned* bar = b.bar;
        __builtin_amdgcn_s_waitcnt(0);
        unsigned nloc = b.st[0], nx = b.st[1];
        if (nloc == 0u) { xcd_barrier_complete(bar, b.x, nloc, nx); b.st[0] = nloc; b.st[1] = nx; }
        const unsigned old = xb_add(&bar[XB_XSUB(b.x)], 1u);
        const unsigned gen = old / nloc;
        if (old + 1u == (gen + 1u) * nloc) {
            __builtin_amdgcn_fence(__ATOMIC_RELEASE, "agent");
            asm volatile("s_waitcnt vmcnt(0)" ::: "memory");
            const unsigned og = xb_add(&bar[XB_TOP], 1u);
            const unsigned tg = og / nx;
            if (og + 1u == (tg + 1u) * nx) xb_add(&bar[XB_TOPGEN], 1u);
            else XB_SPIN(xb_ld(&bar[XB_TOPGEN]) == tg, bar);
            __builtin_amdgcn_fence(__ATOMIC_ACQUIRE, "agent");
            xb_add(&bar[XB_XGEN(b.x)], 1u);
            asm volatile("s_waitcnt vmcnt(0)" ::: "memory");
        } else {
            XB_SPIN(xb_ld(&bar[XB_XGEN(b.x)]) == gen, bar);
            __builtin_amdgcn_fence(__ATOMIC_ACQUIRE, "agent");
            asm volatile("s_waitcnt vmcnt(0)" ::: "memory");
        }
    }
    __syncthreads();
}
constexpr int MISC_OFF = 131072 + 320;

constexpr int N_PHASES = 10;
__global__ void __launch_bounds__(NTHREADS, 2) fwd_kernel(Args args) {
    extern __shared__ __attribute__((aligned(16))) unsigned char lds_raw[];
    Frame F;
    F.lds = (LAS unsigned char*)lds_raw;
    F.tid = threadIdx.x; F.lane = F.tid & 63; F.wave = __builtin_amdgcn_readfirstlane(F.tid >> 6);
    F.G = gridDim.x; { const int bx = blockIdx.x; F.vcu = (F.G % 8 == 0) ? (bx % 8) * (F.G / 8) + bx / 8 : bx; }
    F.a = &args;
    const int lo = args.ph_lo, hi = args.ph_hi;
#ifndef PH_MASK
#define PH_MASK 0x3ff
#endif
#define IN(k) ((((PH_MASK) >> (k)) & 1) && lo <= (k) && (k) < hi)
#if MK_MULTI
#define SEAM(k) do { } while (0)
#elif MK_USE_CG
    cg::grid_group grid = cg::this_grid();
#define SEAM(k) do { if (IN(k) && IN((k) + 1)) grid.sync(); } while (0)
#else
    volatile LAS unsigned* MISC = (volatile LAS unsigned*)(F.lds + MISC_OFF);
    if (F.tid < 32) MISC[F.tid] = 0u;
    __syncthreads();
    XcdBarrier bar = xcd_barrier_post((unsigned*)(args.ws + WS_CTL), MISC + 8);
#ifdef PROBE_PHASE
    if (blockIdx.x == 0 && F.tid == 0) { const unsigned long long t0 = __builtin_amdgcn_s_memrealtime(); MISC[16] = (unsigned)t0; MISC[17] = (unsigned)(t0 >> 32); MISC[18] = 0u; }
#define SEAM(k) do { if (IN(k) && IN((k) + 1)) xcd_barrier(bar); \
        if (blockIdx.x == 0 && F.tid == 0) { const unsigned long long tn = __builtin_amdgcn_s_memrealtime(); const unsigned long long tp = ((unsigned long long)MISC[17] << 32) | MISC[16]; \
            if ((k) == PROBE_PHASE) MISC[18] = (unsigned)(tn - tp); MISC[16] = (unsigned)tn; MISC[17] = (unsigned)(tn >> 32); } } while (0)
#else
#define SEAM(k) do { if (IN(k) && IN((k) + 1)) xcd_barrier(bar); } while (0)
#endif
#endif
    if (IN(0)) p0_prologue(F);
    SEAM(0);
    if (IN(1)) {
        norm_rows<0>(F);
        for (int i = F.vcu * NTHREADS + F.tid; i < M; i += F.G * NTHREADS) F_RSS[i] = 0.f;
        for (int i = F.vcu * NTHREADS + F.tid; i < 64 * 256; i += F.G * NTHREADS) {
            const int r = i >> 8, c4 = (i & 255) * 4; u32x2 w = {0u, 0u};
            if (r < NMODB) { const f32x4 v = *(const f32x4*)(F_MOD + (size_t)r * 6144 + 3072 + c4); w.x = cvtpk(v.x, v.y); w.y = cvtpk(v.z, v.w); }
            *(u32x2*)(F_SHB + (size_t)r * D + c4) = w; }
    }
    SEAM(1);
    if (IN(2)) {
        pg8::Gemm g{F_XN, F_WIN, MP, NIN, D}; pg8::StaticOrder S; S.init(MP, NIN, F.G, (int)blockIdx.x);
        pg8::EpiInProj E{F_QA, F_KA, F_VA, F_QR, F_KR, F_VR, F_GR, F_out, F_TABR, F_TABT};
        if (F.vcu & 1) { pg8::skinny_gemm<4, pg8::EpiInProj>(F.lds, F_XN + (size_t)MP * D, F_WIN, NIN, D, F.vcu, F.G, E); }
        pg8::gemm_phase<pg8::EpiInProj, pg8::StaticOrder, true, true>(F.lds, g, S, E);
        if (!(F.vcu & 1)) { pg8::skinny_gemm<4, pg8::EpiInProj>(F.lds, F_XN + (size_t)MP * D, F_WIN, NIN, D, F.vcu, F.G, E); }
        { pg8::EpiStoreF32 ES{F_SHW, FF};
          for (int u2 = F.vcu - 192; u2 >= 0 && u2 < 64; u2 += F.G) pg8::skinny_unit<4, pg8::EpiStoreF32>(F.lds, F_SHB, F_W1, D, 0, u2, 0, ES); }
    }
    SEAM(2);
    if (IN(3)) {
        for (int it = 0; it < 2; ++it) {
            const int bh = F.vcu >> 2, qq = F.vcu & 3, rh = qq & 1, c = (qq >> 1) == 0 ? (it == 0 ? 0 : 3) : (it == 0 ? 1 : 2);
            if (F.vcu < 256) prompt_attn_tile(F, bh >> 3, bh & 7, 8 * rh + F.wave, c, F.lds + F.wave * 4096);
        }
        __syncthreads();
        for (int it = F.vcu; it < 512; it += F.G) ret_kv_item(F, it >> 6, (it >> 4) & 3, it & 15);
    }
    SEAM(3);
    if (IN(4)) {
        for (int it = F.vcu; it < 256; it += F.G) { const int bh = it >> 3, qq = it & 7;
            ret_out_item(F, bh >> 2, bh & 3, qq); ret_out_item(F, bh >> 2, bh & 3, 15 - qq); }
        for (int it = F.vcu; it < 256; it += F.G) sample_attn_item(F, it >> 3, it & 7);
        for (int it = F.vcu; it < 128; it += F.G) ret_sample_item(F, it >> 2, it & 3);
    }
    SEAM(4);
    if (IN(5)) {
        pg8::Gemm g{F_MIX, F_WOUT, MP, D, D}; pg8::StaticOrder S; S.init(MP, D, F.G, (int)blockIdx.x);
        pg8::EpiOutProj E{F_xp, F_xs, F_X1, F_XN, F_MOD, F_RSS, F_RSSS};
        if (F.vcu & 1) { pg8::skinny_gemm<1, pg8::EpiOutProj>(F.lds, F_MIX + (size_t)MP * D, F_WOUT, D, D, F.vcu, F.G, E); }
        pg8::gemm_phase<pg8::EpiOutProj, pg8::StaticOrder, true, true>(F.lds, g, S, E);
        if (!(F.vcu & 1)) { pg8::skinny_gemm<1, pg8::EpiOutProj>(F.lds, F_MIX + (size_t)MP * D, F_WOUT, D, D, F.vcu, F.G, E); }
    }
    SEAM(5);
    if (IN(7)) {
        pg8::Gemm g{F_XN, F_W1, MP, FF, D}; pg8::StaticOrder S; S.init(MP, FF, F.G, (int)blockIdx.x);
        pg8::EpiRelu2 E{F_H, FF, F_RSS, F_RSSS, F_SHW};
        if (F.vcu & 1) { pg8::skinny_gemm<4, pg8::EpiRelu2>(F.lds, F_XN + (size_t)MP * D, F_W1, FF, D, F.vcu, F.G, E); }
        pg8::gemm_phase<pg8::EpiRelu2, pg8::StaticOrder, true, true>(F.lds, g, S, E);
        if (!(F.vcu & 1)) { pg8::skinny_gemm<4, pg8::EpiRelu2>(F.lds, F_XN + (size_t)MP * D, F_W1, FF, D, F.vcu, F.G, E); }
    }
    SEAM(7);
    if (IN(8)) {
        pg8::Gemm g{F_H, F_W2, MP, D, FF}; pg8::StaticOrder S; S.init(MP, D, F.G, (int)blockIdx.x);
        pg8::EpiResid<false> E{nullptr, nullptr, F_X1, F_MOD + 5120, 6144};
        if (F.vcu & 1) { pg8::skinny_gemm<1, pg8::EpiResid<false>>(F.lds, F_H + (size_t)MP * FF, F_W2, D, FF, F.vcu, F.G, E); }
        pg8::gemm_phase<pg8::EpiResid<false>, pg8::StaticOrder, true, true>(F.lds, g, S, E);
        if (!(F.vcu & 1)) { pg8::skinny_gemm<1, pg8::EpiResid<false>>(F.lds, F_H + (size_t)MP * FF, F_W2, D, FF, F.vcu, F.G, E); }
    }
    SEAM(8);
    if (IN(9)) norm_rows<2>(F);
#if defined(PROBE_PHASE) && !MK_MULTI && !MK_USE_CG
    SEAM(9);
    if (blockIdx.x == 0 && F.tid == 0) { const unsigned long long t0 = __builtin_amdgcn_s_memrealtime(), span = (unsigned long long)MISC[18] * PROBE_AMP;
        while (__builtin_amdgcn_s_memrealtime() - t0 < span) __builtin_amdgcn_s_sleep(20); }
#endif
#undef IN
#undef SEAM
}

extern "C" void kernel_launch(void* const* d_in, const int* in_sizes, int n_in, void* d_out, int out_size, void* d_ws, size_t ws_size, hipStream_t stream) {
    static int grid = 0;
    if (grid == 0) {
        if (n_in != 16 || out_size != OUT_TOTAL || ws_size < WS_END) { fprintf(stderr, "kernel_launch: unexpected problem shape (n_in %d out %d ws %zu)\n", n_in, out_size, ws_size); grid = -1; return; }
        int dev = 0, cus = 0, per_cu = 0;
        if (hipGetDevice(&dev) != hipSuccess || hipDeviceGetAttribute(&cus, hipDeviceAttributeMultiprocessorCount, dev) != hipSuccess) { grid = -1; return; }
        if (hipFuncSetAttribute((const void*)fwd_kernel, hipFuncAttributeMaxDynamicSharedMemorySize, LDS_BYTES) != hipSuccess) { fprintf(stderr, "kernel_launch: hipFuncSetAttribute failed\n"); grid = -1; return; }
        if (hipOccupancyMaxActiveBlocksPerMultiprocessor(&per_cu, (const void*)fwd_kernel, NTHREADS, LDS_BYTES) != hipSuccess || per_cu < 1) { fprintf(stderr, "kernel_launch: occupancy query says %d\n", per_cu); per_cu = 1; }
        (void)hipGetLastError();
        grid = cus;
        if (grid > cus * per_cu) grid = cus * per_cu;
        if (grid != 256) fprintf(stderr, "kernel_launch: note: grid %d\n", grid);
    }
    if (grid < 0) return;
    if (hipMemsetAsync((char*)d_ws + WS_CTL, 0, 16384, stream) != hipSuccess) { fprintf(stderr, "kernel_launch: memset of the barrier words failed\n"); return; }
    Args a{};
    for (int i = 0; i < 16; ++i) a.in[i] = (const float*)d_in[i];
    a.out = (float*)d_out; a.ws = (unsigned char*)d_ws;
#if MK_MULTI
    for (int p = 0; p < N_PHASES; ++p) { a.ph_lo = p; a.ph_hi = p + 1; hipLaunchKernelGGL(fwd_kernel, dim3(grid), dim3(NTHREADS), LDS_BYTES, stream, a); }
#else
    a.ph_lo = 0; a.ph_hi = N_PHASES;
    void* kargs[] = {&a};
    hipError_t e = hipLaunchCooperativeKernel((const void*)fwd_kernel, dim3(grid), dim3(NTHREADS), kargs, LDS_BYTES, stream);
    if (e != hipSuccess) fprintf(stderr, "kernel_launch: cooperative launch failed: %s (grid %d)\n", hipGetErrorString(e), grid);
#ifdef PROBE_LO
    a.ph_lo = PROBE_LO; a.ph_hi = PROBE_HI;
    for (int p = PROBE_LO; p < PROBE_HI; ++p) { a.ph_lo = p; a.ph_hi = p + 1; hipLaunchKernelGGL(fwd_kernel, dim3(grid), dim3(NTHREADS), LDS_BYTES, stream, a); }
#endif
#endif
}
```
